# Optimizing an MI355X kernel written in HIP

```python
import functools
import jax, jax.numpy as jnp
from jax import lax
import numpy as np

D_MODEL = 1024
BATCH = 8
SEQ = 4096
DEPTH = 4

GRID_W = 64
CTX_LEN = 256
N_MIXERS = 3
EPS = 1e-6

LRU_WIDTH = 1280
LRU_BLOCKS = 10
LRU_BLOCK = LRU_WIDTH // LRU_BLOCKS
LRU_CONV = 4
LRU_C = 8.0

RET_HEADS = 4
RET_DK = 256
RET_DV = 512
RET_DK_TOT = RET_HEADS * RET_DK
RET_DV_TOT = RET_HEADS * RET_DV
RET_CHUNK = 128
RET_THETA_BASE = 10000.0

SWA_HQ = 16
SWA_HKV = 4
SWA_DH = 64
SWA_WINDOW = 128
SWA_BLOCK = 128
ROPE_BASE = 10000.0

D_FF = 3584
N_EXPERTS = 8
TOP_K = 2

N_LAYERS_A = (DEPTH + 2) // 3
N_LAYERS_B = (DEPTH + 1) // 3
N_LAYERS_C = DEPTH // 3
N_DENSE = (DEPTH + 1) // 2
N_MOE = DEPTH // 2

kernel_name = 'hybrid_rglru_retention_swa_moe_dit'


def _rmsnorm(x, g):
    xf = x.astype(jnp.float32)
    y = xf * lax.rsqrt(jnp.mean(xf * xf, axis=-1, keepdims=True) + EPS)
    return (y * g.astype(jnp.float32)).astype(x.dtype)


def _modulate(x, g, shift, scale):
    return _rmsnorm(x, g) * (1 + scale) + shift


def _rotate(x, ang):
    cos = jnp.cos(ang)[:, None, :].astype(x.dtype)
    sin = jnp.sin(ang)[:, None, :].astype(x.dtype)
    x1, x2 = jnp.split(x, 2, axis=-1)
    return jnp.concatenate([x1 * cos - x2 * sin, x2 * cos + x1 * sin], axis=-1)


def _axial_angles(length, dim):
    rows = length // GRID_W
    row = jnp.repeat(jnp.arange(rows, dtype=jnp.float32), GRID_W)
    col = jnp.tile(jnp.arange(GRID_W, dtype=jnp.float32), rows)
    n_freq = dim // 4
    freq = ROPE_BASE ** (-jnp.arange(n_freq, dtype=jnp.float32) / n_freq)
    return jnp.concatenate([row[:, None] * freq, col[:, None] * freq], axis=-1)


def _ret_angles(length):
    n_freq = RET_DK // 2
    theta = RET_THETA_BASE ** (-jnp.arange(n_freq, dtype=jnp.float32) / n_freq)
    return jnp.arange(length, dtype=jnp.float32)[:, None] * theta


def _centred_dwconv(x, w, b):
    length = x.shape[1]
    left = LRU_CONV // 2
    right = LRU_CONV - 1 - left
    xp = jnp.pad(x, ((0, 0), (left, right), (0, 0)))
    return b + sum(xp[:, k:k + length] * w[k] for k in range(LRU_CONV))


def _rglru_coeffs(xr, w_gate, b_gate, lam):
    bsz, length, _ = xr.shape
    xb = xr.reshape(bsz, length, LRU_BLOCKS, LRU_BLOCK)
    gates = jnp.einsum('blnj,gnjk->gblnk', xb, w_gate).reshape(2, bsz, length, LRU_WIDTH)
    gates = gates + b_gate[:, None, None, :]
    r = jax.nn.sigmoid(gates[0])
    i = jax.nn.sigmoid(gates[1])
    log_a = -LRU_C * r * jax.nn.softplus(-lam)
    a = jnp.exp(log_a)
    bx = jnp.sqrt(-jnp.expm1(2.0 * log_a)) * (i * xr)
    return a, bx


def _linear_scan(a, bx, h0, reverse):
    def combine(e1, e2):
        a1, b1 = e1
        a2, b2 = e2
        return a1 * a2, a2 * b1 + b2
    a_cum, b_cum = lax.associative_scan(combine, (a, bx), axis=1, reverse=reverse)
    if h0 is None:
        return b_cum
    return a_cum * h0[:, None, :] + b_cum


def _mixer_rglru(hl, hc, w_in, conv_w, conv_b, w_gate, b_gate, lam, w_out, ctx_out):
    def branches(h):
        y, xr = jnp.split(h @ w_in, 2, axis=-1)
        xr = _centred_dwconv(xr, conv_w, conv_b).astype(jnp.float32)
        return jax.nn.gelu(y), xr
    yl, ul = branches(hl)
    yc, uc = branches(hc)
    h_lat, h_ctx_sum = None, None
    for d, rev in enumerate((False, True)):
        a_c, b_c = _rglru_coeffs(uc, w_gate[d], b_gate[d], lam[d])
        h_ctx = _linear_scan(a_c, b_c, None, rev)
        h0 = h_ctx[:, 0] if rev else h_ctx[:, -1]
        a_l, b_l = _rglru_coeffs(ul, w_gate[d], b_gate[d], lam[d])
        h_l = _linear_scan(a_l, b_l, h0, rev)
        h_lat = h_l if h_lat is None else h_lat + h_l
        h_ctx_sum = h_ctx if h_ctx_sum is None else h_ctx_sum + h_ctx
    ol = (yl * h_lat.astype(yl.dtype)) @ w_out
    oc = (yc * h_ctx_sum.astype(yc.dtype)) @ w_out if ctx_out else None
    return ol, oc


def _retention_dir(q, k, v, log_g, state0):
    bsz, length, heads, _ = q.shape
    dv = v.shape[-1]
    n_chunks = length // RET_CHUNK
    pos = jnp.arange(RET_CHUNK, dtype=jnp.float32)
    lg = log_g.astype(jnp.float32)[:, None]
    diff = pos[:, None] - pos[None, :]
    intra = jnp.where(diff >= 0, jnp.exp(lg[:, :, None] * jnp.maximum(diff, 0.0)), 0.0)
    q_dec = jnp.exp(lg * (pos + 1.0))
    k_dec = jnp.exp(lg * (RET_CHUNK - 1.0 - pos))
    c_dec = jnp.exp(lg * RET_CHUNK)

    def chunks(t):
        return t.reshape(bsz, n_chunks, RET_CHUNK, heads, -1).transpose(1, 0, 3, 2, 4)

    def step(state, qkv):
        qc, kc, vc = qkv
        s = jnp.einsum('bhid,bhjd->bhij', qc, kc) * intra
        o = jnp.einsum('bhij,bhje->bhie', s, vc)
        o = o + jnp.einsum('bhid,bhde->bhie', qc * q_dec[..., None], state)
        state = c_dec[..., None] * state + jnp.einsum('bhjd,bhje->bhde', kc * k_dec[..., None], vc)
        return state, o

    state, o = lax.scan(step, state0, (chunks(q), chunks(k), chunks(v)))
    return o.transpose(1, 0, 3, 2, 4).reshape(bsz, length, heads, dv), state


def _mixer_retention(hl, hc, w_in, log_decay, gn_gain, w_out, ctx_out):
    def project(h, rotate):
        bsz, length, _ = h.shape
        q, k, v, g = jnp.split(h @ w_in, [RET_DK_TOT, 2 * RET_DK_TOT, 2 * RET_DK_TOT + RET_DV_TOT], axis=-1)
        q = q.reshape(bsz, length, RET_HEADS, RET_DK)
        k = k.reshape(bsz, length, RET_HEADS, RET_DK) * (RET_DK ** -0.5)
        v = v.reshape(bsz, length, RET_HEADS, RET_DV)
        if rotate:
            ang = _ret_angles(length)
            q, k = _rotate(q, ang), _rotate(k, ang)
        return q.astype(jnp.float32), k.astype(jnp.float32), v.astype(jnp.float32), g

    def out(o, g):
        bsz, length = o.shape[:2]
        o = o * lax.rsqrt(jnp.mean(o * o, axis=-1, keepdims=True) + EPS)
        o = o.reshape(bsz, length, RET_DV_TOT).astype(g.dtype) * gn_gain
        return (jax.nn.silu(g) * o) @ w_out

    flip = lambda t: jnp.flip(t, axis=1)
    ql, kl, vl, gl = project(hl, True)
    qc, kc, vc, gc = project(hc, False)
    zero = jnp.zeros((hl.shape[0], RET_HEADS, RET_DK, RET_DV), jnp.float32)
    oc_f, st_f = _retention_dir(qc, kc, vc, log_decay[0], zero)
    oc_b, st_b = _retention_dir(flip(qc), flip(kc), flip(vc), log_decay[1], zero)
    ol_f, _ = _retention_dir(ql, kl, vl, log_decay[0], st_f)
    ol_b, _ = _retention_dir(flip(ql), flip(kl), flip(vl), log_decay[1], st_b)
    ol = out(ol_f + flip(ol_b), gl)
    oc = out(oc_f + flip(oc_b), gc) if ctx_out else None
    return ol, oc


def _mixer_swa(hl, hc, w_in, sink, w_out, ctx_out):
    def project(h):
        bsz, length, _ = h.shape
        q, k, v = jnp.split(h @ w_in, [SWA_HQ * SWA_DH, (SWA_HQ + SWA_HKV) * SWA_DH], axis=-1)
        return (q.reshape(bsz, length, SWA_HQ, SWA_DH),
                k.reshape(bsz, length, SWA_HKV, SWA_DH),
                v.reshape(bsz, length, SWA_HKV, SWA_DH))

    ql, kl, vl = project(hl)
    qc, kc, vc = project(hc)
    bsz, seq = hl.shape[:2]
    n_ctx = hc.shape[1]
    groups = SWA_HQ // SWA_HKV
    scale = SWA_DH ** -0.5
    sink_g = sink.reshape(SWA_HKV, groups).astype(jnp.float32)
    ang = _axial_angles(seq, SWA_DH)
    ql, kl = _rotate(ql, ang), _rotate(kl, ang)

    n_blk = seq // SWA_BLOCK
    qb = ql.reshape(bsz, n_blk, SWA_BLOCK, SWA_HKV, groups, SWA_DH)

    def band(t):
        tp = jnp.pad(t, ((0, 0), (SWA_BLOCK, SWA_BLOCK), (0, 0), (0, 0)))
        tp = tp.reshape(bsz, n_blk + 2, SWA_BLOCK, SWA_HKV, SWA_DH)
        return jnp.concatenate([tp[:, :-2], tp[:, 1:-1], tp[:, 2:]], axis=2)

    kb, vb = band(kl), band(vl)
    s_band = jnp.einsum('bnqhgd,bnkhd->bhgnqk', qb, kb, preferred_element_type=jnp.float32) * scale
    s_ctx = jnp.einsum('bnqhgd,bchd->bhgnqc', qb, kc, preferred_element_type=jnp.float32) * scale
    blk = jnp.arange(n_blk)[:, None, None]
    qpos = blk * SWA_BLOCK + jnp.arange(SWA_BLOCK)[None, :, None]
    kpos = (blk - 1) * SWA_BLOCK + jnp.arange(3 * SWA_BLOCK)[None, None, :]
    valid = (jnp.abs(qpos - kpos) <= SWA_WINDOW) & (kpos >= 0) & (kpos < seq)
    s_band = jnp.where(valid, s_band, -jnp.inf)
    sink_col = jnp.broadcast_to(sink_g[None, :, :, None, None, None],
                                (bsz, SWA_HKV, groups, n_blk, SWA_BLOCK, 1))
    p = jax.nn.softmax(jnp.concatenate([s_band, s_ctx, sink_col], axis=-1), axis=-1).astype(vl.dtype)
    pb = p[..., :3 * SWA_BLOCK]
    pc = p[..., 3 * SWA_BLOCK:3 * SWA_BLOCK + n_ctx]
    ol = jnp.einsum('bhgnqk,bnkhd->bnqhgd', pb, vb) + jnp.einsum('bhgnqc,bchd->bnqhgd', pc, vc)
    ol = ol.reshape(bsz, seq, SWA_HQ * SWA_DH) @ w_out
    oc = None
    if ctx_out:
        qcg = qc.reshape(bsz, n_ctx, SWA_HKV, groups, SWA_DH)
        sc = jnp.einsum('bqhgd,bkhd->bhgqk', qcg, kc, preferred_element_type=jnp.float32) * scale
        sink_c = jnp.broadcast_to(sink_g[None, :, :, None, None], (bsz, SWA_HKV, groups, n_ctx, 1))
        pcc = jax.nn.softmax(jnp.concatenate([sc, sink_c], axis=-1), axis=-1)[..., :n_ctx].astype(vc.dtype)
        oc = jnp.einsum('bhgqk,bkhd->bqhgd', pcc, vc).reshape(bsz, n_ctx, SWA_HQ * SWA_DH) @ w_out
    return ol, oc


def _swiglu(h, w_gu, w_down):
    g, u = jnp.split(h @ w_gu, 2, axis=-1)
    return (jax.nn.silu(g) * u) @ w_down


def _moe_swiglu(h, router, w_gu, w_down):
    logits = (h @ router).astype(jnp.float32)
    top_v, top_i = lax.top_k(logits, TOP_K)
    top_w = jax.nn.softmax(top_v, axis=-1)
    combine = jnp.sum(jax.nn.one_hot(top_i, N_EXPERTS, dtype=jnp.float32) * top_w[..., None], axis=1)
    combine = combine.astype(h.dtype)
    out = jnp.zeros_like(h)
    for e in range(N_EXPERTS):
        out = out + combine[:, e:e + 1] * _swiglu(h, w_gu[e], w_down[e])
    return out


def setup_inputs(seed: int = 0) -> dict:
    key = jax.random.key(seed)
    keys = iter(jax.random.split(key, 40))
    f32 = jnp.float32
    D = D_MODEL

    def nrm(shape, fan_in, scale=1.0):
        return scale * (fan_in ** -0.5) * jax.random.normal(next(keys), shape, f32)

    def noise(shape, scale):
        return scale * jax.random.normal(next(keys), shape, f32)

    x = jax.random.normal(next(keys), (BATCH, SEQ, D), f32)
    c = jax.random.normal(next(keys), (BATCH, D), f32)
    ctx = jax.random.normal(next(keys), (BATCH, CTX_LEN, D), f32)
    c_ctx = jax.random.normal(next(keys), (D,), f32)
    ada_w = nrm((DEPTH, D, 6 * D), D, 0.5)
    ada_b = noise((DEPTH, 6 * D), 0.02)
    norm_g = 1.0 + noise((DEPTH, 2, D), 0.05)
    final_g = 1.0 + noise((D,), 0.05)

    lru_w_in = nrm((N_LAYERS_A, D, 2 * LRU_WIDTH), D)
    lru_conv_w = nrm((N_LAYERS_A, LRU_CONV, LRU_WIDTH), LRU_CONV)
    lru_conv_b = noise((N_LAYERS_A, LRU_WIDTH), 0.02)
    lru_w_gate = nrm((N_LAYERS_A, 2, 2, LRU_BLOCKS, LRU_BLOCK, LRU_BLOCK), LRU_BLOCK)
    lru_b_gate = noise((N_LAYERS_A, 2, 2, LRU_WIDTH), 0.1)
    a_pow = jax.random.uniform(next(keys), (N_LAYERS_A, 2, LRU_WIDTH), f32, 0.9, 0.999)
    p = a_pow ** (1.0 / LRU_C)
    lru_lambda = jnp.log(p) - jnp.log1p(-p)
    lru_w_out = nrm((N_LAYERS_A, LRU_WIDTH, D), LRU_WIDTH)

    ret_w_in = nrm((N_LAYERS_B, D, 2 * RET_DK_TOT + 2 * RET_DV_TOT), D)
    head = jnp.arange(RET_HEADS, dtype=f32)
    jitter = jax.random.uniform(next(keys), (N_LAYERS_B, 2, RET_HEADS), f32, 0.0, 0.5)
    ret_log_decay = jnp.log(1.0 - 2.0 ** (-5.0 - head - jitter))
    ret_gn_gain = 1.0 + noise((N_LAYERS_B, RET_DV_TOT), 0.05)
    ret_w_out = nrm((N_LAYERS_B, RET_DV_TOT, D), RET_DV_TOT)

    swa_w_in = nrm((N_LAYERS_C, D, (SWA_HQ + 2 * SWA_HKV) * SWA_DH), D)
    swa_sink = noise((N_LAYERS_C, SWA_HQ), 0.5)
    swa_w_out = nrm((N_LAYERS_C, SWA_HQ * SWA_DH, D), SWA_HQ * SWA_DH)

    ffn_w_gu = nrm((N_DENSE, D, 2 * D_FF), D)
    ffn_w_down = nrm((N_DENSE, D_FF, D), D_FF)
    moe_router = nrm((N_MOE, D, N_EXPERTS), D)
    moe_w_gu = nrm((N_MOE, N_EXPERTS, D, 2 * D_FF), D)
    moe_w_down = nrm((N_MOE, N_EXPERTS, D_FF, D), D_FF)
    return {
        'x': x, 'c': c, 'ctx': ctx, 'c_ctx': c_ctx,
        'ada_w': ada_w, 'ada_b': ada_b, 'norm_g': norm_g, 'final_g': final_g,
        'lru_w_in': lru_w_in, 'lru_conv_w': lru_conv_w, 'lru_conv_b': lru_conv_b,
        'lru_w_gate': lru_w_gate, 'lru_b_gate': lru_b_gate, 'lru_lambda': lru_lambda,
        'lru_w_out': lru_w_out,
        'ret_w_in': ret_w_in, 'ret_log_decay': ret_log_decay, 'ret_gn_gain': ret_gn_gain,
        'ret_w_out': ret_w_out,
        'swa_w_in': swa_w_in, 'swa_sink': swa_sink, 'swa_w_out': swa_w_out,
        'ffn_w_gu': ffn_w_gu, 'ffn_w_down': ffn_w_down,
        'moe_router': moe_router, 'moe_w_gu': moe_w_gu, 'moe_w_down': moe_w_down,
    }


def reference(x, c, ctx, c_ctx, ada_w, ada_b, norm_g, final_g,
              lru_w_in, lru_conv_w, lru_conv_b, lru_w_gate, lru_b_gate, lru_lambda, lru_w_out,
              ret_w_in, ret_log_decay, ret_gn_gain, ret_w_out,
              swa_w_in, swa_sink, swa_w_out,
              ffn_w_gu, ffn_w_down,
              moe_router, moe_w_gu, moe_w_down):
    bsz, seq, dm = x.shape
    n_ctx = ctx.shape[1]
    cond_l = jax.nn.silu(c)
    cond_c = jax.nn.silu(c_ctx)
    xl, xc = x, ctx
    for i in range(DEPTH):
        last = i == DEPTH - 1
        mod_l = jnp.split((cond_l @ ada_w[i] + ada_b[i])[:, None, :], 6, axis=-1)
        mod_c = jnp.split(cond_c @ ada_w[i] + ada_b[i], 6, axis=-1)
        hl = _modulate(xl, norm_g[i, 0], mod_l[0], mod_l[1])
        hc = _modulate(xc, norm_g[i, 0], mod_c[0], mod_c[1])
        j = i // N_MIXERS
        if i % N_MIXERS == 0:
            ol, oc = _mixer_rglru(hl, hc, lru_w_in[j], lru_conv_w[j], lru_conv_b[j], lru_w_gate[j],
                                  lru_b_gate[j], lru_lambda[j], lru_w_out[j], not last)
        elif i % N_MIXERS == 1:
            ol, oc = _mixer_retention(hl, hc, ret_w_in[j], ret_log_decay[j], ret_gn_gain[j],
                                      ret_w_out[j], not last)
        else:
            ol, oc = _mixer_swa(hl, hc, swa_w_in[j], swa_sink[j], swa_w_out[j], not last)
        xl = xl + mod_l[2] * ol
        hl = _modulate(xl, norm_g[i, 1], mod_l[3], mod_l[4])
        f = i // 2
        if i % 2 == 0:
            ffn = functools.partial(_swiglu, w_gu=ffn_w_gu[f], w_down=ffn_w_down[f])
        else:
            ffn = functools.partial(_moe_swiglu, router=moe_router[f], w_gu=moe_w_gu[f], w_down=moe_w_down[f])
        if last:
            xl = xl + mod_l[5] * ffn(hl.reshape(-1, dm)).reshape(bsz, seq, dm)
        else:
            xc = xc + mod_c[2] * oc
            hc = _modulate(xc, norm_g[i, 1], mod_c[3], mod_c[4])
            y = ffn(jnp.concatenate([hl.reshape(-1, dm), hc.reshape(-1, dm)], axis=0))
            xl = xl + mod_l[5] * y[:bsz * seq].reshape(bsz, seq, dm)
            xc = xc + mod_c[5] * y[bsz * seq:].reshape(bsz, n_ctx, dm)
    return _rmsnorm(xl, final_g)
```

```cpp
#ifndef CPU_SHIM
#include <hip/hip_runtime.h>
#include <cstdio>
#include <cstdint>
#define HD __host__ __device__ __forceinline__
#define DV __device__ __forceinline__
#else
#include <cmath>
#include <cstring>
#include <cstddef>
#include <cstdio>
#define HD inline
#define DV inline
#endif

#ifdef CFG_SMALL
constexpr int D_MODEL = 64, BATCH = 2, SEQ = 512, CTX = 256, LRU_NB = 3, LRU_BS = 16, RET_H = 2, RET_DK = 16, RET_DV = 32, SWA_HQ = 4, SWA_HKV = 2, SWA_DH = 16, D_FF = 96;
#else
constexpr int D_MODEL = 1024, BATCH = 8, SEQ = 4096, CTX = 256, LRU_NB = 10, LRU_BS = 128, RET_H = 4, RET_DK = 256, RET_DV = 512, SWA_HQ = 16, SWA_HKV = 4, SWA_DH = 64, D_FF = 3584;
#endif
constexpr int DEPTH = 4, GRID_W = 64, NEXP = 8, LRU_W = LRU_NB * LRU_BS, RET_DKT = RET_H * RET_DK, RET_DVT = RET_H * RET_DV;
constexpr int SCH = 128;
constexpr int SWA_BLK = 128, SWA_WIN = 128, SWA_G = SWA_HQ / SWA_HKV, SWA_NQ = SWA_HQ * SWA_DH, SWA_NKV = SWA_HKV * SWA_DH, SWA_N = SWA_NQ + 2 * SWA_NKV;
constexpr int M_LAT = BATCH * SEQ, M_CTX = BATCH * CTX, M_ALL = M_LAT + M_CTX, NMOD = BATCH + 1;
constexpr int NCHK = (CTX + SEQ) / SCH, NCHK_C = CTX / SCH;
constexpr int RET_NQKG = 2 * RET_DKT + RET_DVT, RET_NKV = RET_DKT + RET_DVT;
constexpr int MAXSLOT = 2 * M_ALL + NEXP * 256, MAXTILE = MAXSLOT / 256;
constexpr float EPS = 1e-6f;
enum { I_X = 0, I_C, I_CTX, I_CCTX, I_ADAW, I_ADAB, I_NORMG, I_FINALG, I_LRU_WIN, I_LRU_CW, I_LRU_CB, I_LRU_WG, I_LRU_BG, I_LRU_LAM, I_LRU_WOUT,
       I_RET_WIN, I_RET_LD, I_RET_GN, I_RET_WOUT, I_SWA_WIN, I_SWA_SINK, I_SWA_WOUT, I_FFN_GU, I_FFN_DN, I_MOE_R, I_MOE_GU, I_MOE_DN, N_IN };

constexpr size_t al256(size_t x) { return (x + 255) & ~size_t(255); }
constexpr size_t OFF_CTL = 0, SZ_CTL = 1u << 20;
constexpr size_t OFF_MOD = OFF_CTL + SZ_CTL;
constexpr size_t OFF_SP8 = OFF_MOD + al256((size_t)DEPTH * NMOD * 6 * D_MODEL * 4);
constexpr size_t OFF_RCOS = OFF_SP8 + al256((size_t)4 * LRU_W * 4);
constexpr size_t OFF_RSIN = OFF_RCOS + al256((size_t)SEQ * (RET_DK / 2) * 4);
constexpr size_t OFF_SCOS = OFF_RSIN + al256((size_t)SEQ * (RET_DK / 2) * 4);
constexpr size_t OFF_SSIN = OFF_SCOS + al256((size_t)SEQ * (SWA_DH / 2) * 4);
constexpr size_t OFF_TOPI = OFF_SSIN + al256((size_t)SEQ * (SWA_DH / 2) * 4);
constexpr size_t OFF_TOPW = OFF_TOPI + al256((size_t)M_ALL * 2 * 4);
constexpr size_t OFF_SLOT = OFF_TOPW + al256((size_t)M_ALL * 2 * 4);
constexpr size_t OFF_TILEE = OFF_SLOT + al256((size_t)M_ALL * 2 * 4);
constexpr size_t OFF_PSP = OFF_TILEE + al256((size_t)MAXTILE * 4);
constexpr size_t SZ_PS = al256((size_t)BATCH * 2 * NCHK * LRU_W * 4);
constexpr size_t OFF_PSS = OFF_PSP + SZ_PS, OFF_CIN = OFF_PSS + SZ_PS;
constexpr size_t OFF_WB = al256(OFF_CIN + SZ_PS);
constexpr size_t SZ_W_LRU_IN = (size_t)2 * LRU_W * D_MODEL * 2, SZ_W_LRU_G = (size_t)4 * LRU_W * 256 * 2, SZ_W_LRU_OUT = (size_t)D_MODEL * LRU_W * 2;
constexpr size_t OFF_W_LRU_IN = OFF_WB, OFF_W_LRU_G = OFF_W_LRU_IN + 2 * SZ_W_LRU_IN, OFF_W_LRU_OUT = OFF_W_LRU_G + 2 * SZ_W_LRU_G;
constexpr size_t OFF_W_RET_A = OFF_W_LRU_OUT + 2 * SZ_W_LRU_OUT;
constexpr size_t OFF_W_RET_B = OFF_W_RET_A + (size_t)RET_NQKG * D_MODEL * 2;
constexpr size_t OFF_W_RET_OUT = OFF_W_RET_B + (size_t)RET_NKV * D_MODEL * 2;
constexpr size_t OFF_W_SWA_IN = OFF_W_RET_OUT + (size_t)D_MODEL * RET_DVT * 2;
constexpr size_t OFF_W_SWA_OUT = OFF_W_SWA_IN + (size_t)SWA_N * D_MODEL * 2;
constexpr size_t SZ_W_GU = (size_t)2 * D_FF * D_MODEL * 2, SZ_W_DN = (size_t)D_MODEL * D_FF * 2;
constexpr size_t OFF_W_FFN_GU = OFF_W_SWA_OUT + (size_t)D_MODEL * SWA_NQ * 2, OFF_W_FFN_DN = OFF_W_FFN_GU + 2 * SZ_W_GU;
constexpr size_t OFF_W_MOE_GU = OFF_W_FFN_DN + 2 * SZ_W_DN, OFF_W_MOE_DN = OFF_W_MOE_GU + 2 * NEXP * SZ_W_GU;
constexpr size_t OFF_XL = al256(OFF_W_MOE_DN + 2 * NEXP * SZ_W_DN);
constexpr size_t OFF_H = OFF_XL + (size_t)M_ALL * D_MODEL * 4;
constexpr size_t OFF_DYN = al256(OFF_H + (size_t)M_ALL * D_MODEL * 2);
constexpr size_t OFF_Y1 = OFF_DYN;
constexpr size_t OFF_U = OFF_Y1 + (size_t)M_ALL * 2 * LRU_W * 2;
constexpr size_t OFF_GT = OFF_U + (size_t)M_ALL * LRU_W * 2;
constexpr size_t OFF_TMP = OFF_GT + (size_t)M_ALL * 4 * LRU_W * 2;
constexpr size_t OFF_A2 = OFF_TMP + (size_t)M_ALL * LRU_W * 4;
constexpr size_t END_LRU = OFF_A2 + (size_t)M_ALL * LRU_W * 2;
constexpr size_t OFF_QKG = OFF_DYN;
constexpr size_t OFF_KVT = OFF_QKG + (size_t)M_ALL * RET_NQKG * 2;
constexpr size_t OFF_OF = OFF_KVT + (size_t)RET_NKV * M_ALL * 2;
constexpr size_t OFF_OB = OFF_OF + (size_t)M_ALL * RET_DVT * 2;
constexpr size_t OFF_A3 = OFF_OB + (size_t)M_ALL * RET_DVT * 2;
constexpr size_t END_RET = OFF_A3 + (size_t)M_ALL * RET_DVT * 2;
constexpr size_t OFF_QKV = OFF_DYN;
constexpr size_t OFF_AO = OFF_QKV + (size_t)M_ALL * SWA_N * 2;
constexpr size_t END_SWA = OFF_AO + (size_t)M_ALL * SWA_NQ * 2;
constexpr size_t OFF_HID = OFF_DYN;
constexpr size_t END_FFN = OFF_HID + (size_t)M_ALL * D_FF * 2;
constexpr size_t OFF_YP = OFF_DYN;
constexpr size_t OFF_AG = OFF_YP + (size_t)MAXSLOT * D_MODEL * 2;
constexpr size_t OFF_HIDM = OFF_AG + (size_t)MAXSLOT * D_MODEL * 2;
constexpr size_t END_MOE = OFF_HIDM + (size_t)MAXSLOT * D_FF * 2;
constexpr size_t cmax(size_t a, size_t b) { return a > b ? a : b; }
constexpr size_t WS_NEED = cmax(cmax(END_LRU, END_RET), cmax(cmax(END_SWA, END_FFN), END_MOE));
constexpr int CW_CNT = 64;
constexpr int CW_CUR = 256;
constexpr int CW_CHK = 1024;
constexpr int CW_BAR = 8192;

struct Ctx { const float* in[N_IN]; float* out; unsigned char* ws; };
template <class T> HD T* wsp(const Ctx& c, size_t off) { return (T*)(c.ws + off); }

typedef unsigned short bf16;
HD float bf2f(bf16 b) { unsigned u = ((unsigned)b) << 16; float f; __builtin_memcpy(&f, &u, 4); return f; }
HD bf16 f2bf(float f) { unsigned u; __builtin_memcpy(&u, &f, 4); u += 0x7fffu + ((u >> 16) & 1u); return (bf16)(u >> 16); }
HD float bfr(float f) { return bf2f(f2bf(f)); }
HD float sigmoidf_(float x) { return 1.0f / (1.0f + expf(-x)); }
HD float siluf_(float x) { return x / (1.0f + expf(-x)); }
HD float geluf_(float x) { return 0.5f * x * (1.0f + tanhf(0.7978845608028654f * (x + 0.044715f * x * x * x))); }

struct RowInfo { int mrow, t, L, seq0; };
HD RowInfo row_info(int row) {
    RowInfo r;
    if (row < M_LAT) { const int b = row / SEQ; r.mrow = b; r.t = row % SEQ; r.L = SEQ; r.seq0 = b * SEQ; }
    else { const int q = row - M_LAT, b = q / CTX; r.mrow = BATCH; r.t = q % CTX; r.L = CTX; r.seq0 = M_LAT + b * CTX; }
    return r;
}
HD const float* modp(const Ctx& c, int layer, int mrow, int which) { return wsp<float>(c, OFF_MOD) + ((size_t)(layer * NMOD + mrow) * 6 + which) * D_MODEL; }

DV void ph_mod(const Ctx& c, int gtid, int gn) {
    float* MOD = wsp<float>(c, OFF_MOD);
    const int N6 = 6 * D_MODEL;
    for (int idx = gtid; idx < DEPTH * N6; idx += gn) {
        const int l = idx / N6, j = idx % N6;
        float acc[NMOD];
#pragma unroll
        for (int r = 0; r < NMOD; ++r) acc[r] = 0.f;
        for (int k = 0; k < D_MODEL; ++k) {
            const float w = c.in[I_ADAW][((size_t)l * D_MODEL + k) * N6 + j];
#pragma unroll
            for (int r = 0; r < BATCH; ++r) acc[r] += siluf_(c.in[I_C][r * D_MODEL + k]) * w;
            acc[BATCH] += siluf_(c.in[I_CCTX][k]) * w;
        }
        const float b = c.in[I_ADAB][l * N6 + j];
#pragma unroll
        for (int r = 0; r < NMOD; ++r) MOD[((size_t)(l * NMOD + r)) * N6 + j] = acc[r] + b;
    }
}
DV void ph_tables(const Ctx& c, int gtid, int gn) {
    float* SP8 = wsp<float>(c, OFF_SP8);
    for (int i = gtid; i < 4 * LRU_W; i += gn) SP8[i] = (float)(8.0 * log1p(exp(-(double)c.in[I_LRU_LAM][i])));
    float* RC = wsp<float>(c, OFF_RCOS); float* RS = wsp<float>(c, OFF_RSIN);
    constexpr int NF = RET_DK / 2;
    for (int i = gtid; i < SEQ * NF; i += gn) {
        const int t = i / NF, f = i % NF; const double th = pow(10000.0, -(double)f / NF), a = (double)t * th;
        RC[i] = (float)cos(a); RS[i] = (float)sin(a);
    }
    float* SC = wsp<float>(c, OFF_SCOS); float* SS = wsp<float>(c, OFF_SSIN);
    constexpr int HF = SWA_DH / 2, QF = SWA_DH / 4;
    for (int i = gtid; i < SEQ * HF; i += gn) {
        const int t = i / HF, f = i % HF; const int pos = f < QF ? t / GRID_W : t % GRID_W;
        const double fr = pow(10000.0, -(double)(f % QF) / QF), a = (double)pos * fr;
        SC[i] = (float)cos(a); SS[i] = (float)sin(a);
    }
}
DV void ph_copy_x(const Ctx& c, int gtid, int gn) {
    float* XL = wsp<float>(c, OFF_XL);
    const size_t n4 = (size_t)M_ALL * D_MODEL / 4, nl4 = (size_t)M_LAT * D_MODEL / 4;
    typedef float f4 __attribute__((ext_vector_type(4)));
    for (size_t i = gtid; i < n4; i += gn) ((f4*)XL)[i] = i < nl4 ? ((const f4*)c.in[I_X])[i] : ((const f4*)c.in[I_CTX])[i - nl4];
}

HD float spec_rstd(const float* xr) { float ss = 0.f; for (int k = 0; k < D_MODEL; ++k) ss += xr[k] * xr[k]; return 1.0f / sqrtf(ss / D_MODEL + EPS); }
HD float spec_norm(const Ctx& c, int layer, int which, int row, int col, float rstd) {
    const RowInfo ri = row_info(row); const float* xr = wsp<float>(c, OFF_XL) + (size_t)row * D_MODEL;
    const float g = c.in[I_NORMG][(layer * 2 + which) * D_MODEL + col];
    return xr[col] * rstd * g * (1.0f + modp(c, layer, ri.mrow, which * 3 + 1)[col]) + modp(c, layer, ri.mrow, which * 3 + 0)[col];
}
HD void top2(const float (&lg)[NEXP], int& i0, int& i1, float& w0, float& w1) {
    float v0 = lg[0], v1 = -3.0e38f; int a0 = 0, a1 = 1;
#pragma unroll
    for (int e = 1; e < NEXP; ++e) { const float x = lg[e]; const bool g0 = x > v0, g1 = x > v1;
        const float nv1 = g0 ? v0 : (g1 ? x : v1); const int na1 = g0 ? a0 : (g1 ? e : a1);
        v0 = g0 ? x : v0; a0 = g0 ? e : a0; v1 = nv1; a1 = na1; }
    i0 = a0; i1 = a1; w0 = 1.0f / (1.0f + expf(v1 - v0)); w1 = 1.0f - w0;
}
HD float spec_dot(const bf16* a, const float* w, int ldw, int K, int col) { float s = 0.f; for (int k = 0; k < K; ++k) s += bf2f(a[k]) * bfr(w[(size_t)k * ldw + col]); return s; }
HD float spec_conv(const Ctx& c, int j, int row, int ch) {
    const RowInfo ri = row_info(row); const bf16* Y1 = wsp<bf16>(c, OFF_Y1);
    float s = c.in[I_LRU_CB][j * LRU_W + ch];
#pragma unroll
    for (int k = 0; k < 4; ++k) { const int tt = ri.t + k - 2; if (tt >= 0 && tt < ri.L) s += bf2f(Y1[(size_t)(ri.seq0 + tt) * (2 * LRU_W) + LRU_W + ch]) * c.in[I_LRU_CW][(j * 4 + k) * LRU_W + ch]; }
    return s;
}
HD float spec_gate(const Ctx& c, int j, int row, int q, int ch) {
    const bf16* U = wsp<bf16>(c, OFF_U) + (size_t)row * LRU_W; const int blk = ch / LRU_BS, kk = ch % LRU_BS;
    const float* w = c.in[I_LRU_WG] + ((size_t)(j * 4 + q) * LRU_NB + blk) * LRU_BS * LRU_BS;
    float s = 0.f; for (int jj = 0; jj < LRU_BS; ++jj) s += bf2f(U[blk * LRU_BS + jj]) * bfr(w[jj * LRU_BS + kk]);
    return s;
}
HD void lru_coef(const Ctx& c, int j, int row, int d, int ch, float& a, float& bx) {
    const bf16* GT = wsp<bf16>(c, OFF_GT) + (size_t)row * (4 * LRU_W);
    const float gr = bf2f(GT[(d * 2 + 0) * LRU_W + ch]) + c.in[I_LRU_BG][((j * 2 + d) * 2 + 0) * LRU_W + ch];
    const float gi = bf2f(GT[(d * 2 + 1) * LRU_W + ch]) + c.in[I_LRU_BG][((j * 2 + d) * 2 + 1) * LRU_W + ch];
    const float r = sigmoidf_(gr), i = sigmoidf_(gi), la = -wsp<float>(c, OFF_SP8)[(j * 2 + d) * LRU_W + ch] * r;
    a = expf(la); bx = sqrtf(-expm1f(2.0f * la)) * (i * bf2f(wsp<bf16>(c, OFF_U)[(size_t)row * LRU_W + ch]));
}
HD int chunk_row0(int b, int cidx) { return cidx < NCHK_C ? M_LAT + b * CTX + cidx * SCH : b * SEQ + (cidx - NCHK_C) * SCH; }
HD int chunk_at(int d, int s) { if (d == 0) return s; return s < NCHK_C ? NCHK_C - 1 - s : NCHK_C + (NCHK - 1 - s); }
DV void ph_scan1(const Ctx& c, int j, int gtid, int gn) {
    float* PSP = wsp<float>(c, OFF_PSP); float* PSS = wsp<float>(c, OFF_PSS);
    for (int idx = gtid; idx < BATCH * 2 * NCHK * LRU_W; idx += gn) {
        const int ch = idx % LRU_W, cidx = (idx / LRU_W) % NCHK, d = (idx / (LRU_W * NCHK)) % 2, b = idx / (LRU_W * NCHK * 2);
        const int r0 = chunk_row0(b, cidx); float P = 1.f, S = 0.f;
        for (int s = 0; s < SCH; ++s) { const int row = r0 + (d == 0 ? s : SCH - 1 - s); float a, bx; lru_coef(c, j, row, d, ch, a, bx); P *= a; S = a * S + bx; }
        PSP[idx] = P; PSS[idx] = S;
    }
}
DV void ph_scan2(const Ctx& c, int gtid, int gn) {
    const float* PSP = wsp<float>(c, OFF_PSP); const float* PSS = wsp<float>(c, OFF_PSS); float* CIN = wsp<float>(c, OFF_CIN);
    for (int idx = gtid; idx < BATCH * 2 * LRU_W; idx += gn) {
        const int ch = idx % LRU_W, d = (idx / LRU_W) % 2, b = idx / (LRU_W * 2); float st = 0.f;
        for (int s = 0; s < NCHK; ++s) { const int cidx = chunk_at(d, s); const size_t o = ((size_t)(b * 2 + d) * NCHK + cidx) * LRU_W + ch; CIN[o] = st; st = PSP[o] * st + PSS[o]; }
    }
}
DV void ph_scan3(const Ctx& c, int j, int gtid, int gn) {
    const float* CIN = wsp<float>(c, OFF_CIN); float* TMP = wsp<float>(c, OFF_TMP); bf16* A2 = wsp<bf16>(c, OFF_A2); const bf16* Y1 = wsp<bf16>(c, OFF_Y1);
    for (int idx = gtid; idx < BATCH * NCHK * LRU_W; idx += gn) {
        const int ch = idx % LRU_W, cidx = (idx / LRU_W) % NCHK, b = idx / (LRU_W * NCHK); const int r0 = chunk_row0(b, cidx);
        float h = CIN[((size_t)(b * 2 + 0) * NCHK + cidx) * LRU_W + ch];
        for (int s = 0; s < SCH; ++s) { const int row = r0 + s; float a, bx; lru_coef(c, j, row, 0, ch, a, bx); h = a * h + bx; TMP[(size_t)row * LRU_W + ch] = h; }
        h = CIN[((size_t)(b * 2 + 1) * NCHK + cidx) * LRU_W + ch];
        for (int s = SCH - 1; s >= 0; --s) { const int row = r0 + s; float a, bx; lru_coef(c, j, row, 1, ch, a, bx); h = a * h + bx;
            A2[(size_t)row * LRU_W + ch] = f2bf(geluf_(bf2f(Y1[(size_t)row * (2 * LRU_W) + ch])) * (TMP[(size_t)row * LRU_W + ch] + h)); }
    }
}
DV void ph_conv(const Ctx& c, int j, int gtid, int gn) {
    bf16* U = wsp<bf16>(c, OFF_U);
    for (size_t idx = gtid; idx < (size_t)M_ALL * LRU_W; idx += gn) U[idx] = f2bf(spec_conv(c, j, (int)(idx / LRU_W), (int)(idx % LRU_W)));
}

DV void ph_ret_rope(const Ctx& c, int gtid, int gn) {
    bf16* QKG = wsp<bf16>(c, OFF_QKG); bf16* KVT = wsp<bf16>(c, OFF_KVT);
    const float* RC = wsp<float>(c, OFF_RCOS); const float* RS = wsp<float>(c, OFF_RSIN);
    constexpr int NF = RET_DK / 2; const float ksc = 1.0f / sqrtf((float)RET_DK);
    for (size_t idx = gtid; idx < (size_t)M_ALL * RET_H * NF; idx += gn) {
        const int i = (int)(idx % NF), h = (int)((idx / NF) % RET_H), row = (int)(idx / ((size_t)NF * RET_H));
        float cs = 1.f, sn = 0.f; if (row < M_LAT) { const int t = row % SEQ; cs = RC[t * NF + i]; sn = RS[t * NF + i]; }
        bf16* q = QKG + (size_t)row * RET_NQKG + h * RET_DK; bf16* k = q + RET_DKT;
        const float q1 = bf2f(q[i]), q2 = bf2f(q[i + NF]); q[i] = f2bf(q1 * cs - q2 * sn); q[i + NF] = f2bf(q2 * cs + q1 * sn);
        const float k1 = bf2f(k[i]) * ksc, k2 = bf2f(k[i + NF]) * ksc; k[i] = f2bf(k1 * cs - k2 * sn); k[i + NF] = f2bf(k2 * cs + k1 * sn);
    }
    for (size_t idx = gtid; idx < (size_t)M_ALL * RET_H * NF; idx += gn) {
        const int row = (int)(idx % M_ALL), i = (int)((idx / M_ALL) % NF), h = (int)(idx / ((size_t)M_ALL * NF));
        float cs = 1.f, sn = 0.f; if (row < M_LAT) { const int t = row % SEQ; cs = RC[t * NF + i]; sn = RS[t * NF + i]; }
        bf16* kt1 = KVT + (size_t)(h * RET_DK + i) * M_ALL + row; bf16* kt2 = KVT + (size_t)(h * RET_DK + i + NF) * M_ALL + row;
        const float t1 = bf2f(*kt1) * ksc, t2 = bf2f(*kt2) * ksc; *kt1 = f2bf(t1 * cs - t2 * sn); *kt2 = f2bf(t2 * cs + t1 * sn);
    }
}
HD int ret_row_at(int b, int d, int p) { if (p < CTX) return M_LAT + b * CTX + (d == 0 ? p : CTX - 1 - p); const int q = p - CTX; return b * SEQ + (d == 0 ? q : SEQ - 1 - q); }
HD int ret_pos_of(int row, int d, int& b) { if (row < M_LAT) { b = row / SEQ; const int t = row % SEQ; return CTX + (d == 0 ? t : SEQ - 1 - t); } const int q = row - M_LAT; b = q / CTX; const int s = q % CTX; return d == 0 ? s : CTX - 1 - s; }
HD float spec_ret(const Ctx& c, int row, int h, int e, int d) {
    const bf16* QKG = wsp<bf16>(c, OFF_QKG); const bf16* KVT = wsp<bf16>(c, OFF_KVT);
    const float lg = c.in[I_RET_LD][d * RET_H + h]; int b; const int p = ret_pos_of(row, d, b);
    const bf16* q = QKG + (size_t)row * RET_NQKG + h * RET_DK; const bf16* vt = KVT + (size_t)(RET_DKT + h * RET_DV + e) * M_ALL;
    float o = 0.f;
    for (int s = 0; s <= p; ++s) { const int rs = ret_row_at(b, d, s); const bf16* k = QKG + (size_t)rs * RET_NQKG + RET_DKT + h * RET_DK;
        float dot = 0.f; for (int x = 0; x < RET_DK; ++x) dot += bf2f(q[x]) * bf2f(k[x]);
        o += expf(lg * (float)(p - s)) * dot * bf2f(vt[rs]); }
    return o;
}
HD float spec_ret_comb(const Ctx& c, int row, int h, int e) {
    const bf16* OF = wsp<bf16>(c, OFF_OF) + (size_t)row * RET_DVT + h * RET_DV; const bf16* OB = wsp<bf16>(c, OFF_OB) + (size_t)row * RET_DVT + h * RET_DV;
    float ss = 0.f; for (int x = 0; x < RET_DV; ++x) { const float o = bf2f(OF[x]) + bf2f(OB[x]); ss += o * o; }
    const float o = bf2f(OF[e]) + bf2f(OB[e]), g = bf2f(wsp<bf16>(c, OFF_QKG)[(size_t)row * RET_NQKG + 2 * RET_DKT + h * RET_DV + e]);
    return siluf_(g) * (o / sqrtf(ss / RET_DV + EPS)) * c.in[I_RET_GN][h * RET_DV + e];
}

DV void ph_swa_rope(const Ctx& c, int gtid, int gn) {
    bf16* QKV = wsp<bf16>(c, OFF_QKV); const float* SC = wsp<float>(c, OFF_SCOS); const float* SS = wsp<float>(c, OFF_SSIN);
    constexpr int HF = SWA_DH / 2, NH = SWA_HQ + SWA_HKV;
    for (size_t idx = gtid; idx < (size_t)M_LAT * NH * HF; idx += gn) {
        const int i = (int)(idx % HF), hh = (int)((idx / HF) % NH), row = (int)(idx / ((size_t)HF * NH)); const int t = row % SEQ;
        bf16* p = QKV + (size_t)row * SWA_N + hh * SWA_DH; const float cs = SC[t * HF + i], sn = SS[t * HF + i];
        const float x1 = bf2f(p[i]), x2 = bf2f(p[i + HF]); p[i] = f2bf(x1 * cs - x2 * sn); p[i + HF] = f2bf(x2 * cs + x1 * sn);
    }
}
HD float swa_score(const bf16* q, const bf16* k) { float s = 0.f; for (int x = 0; x < SWA_DH; ++x) s += bf2f(q[x]) * bf2f(k[x]); return s * (1.0f / sqrtf((float)SWA_DH)); }
HD float spec_swa(const Ctx& c, int row, int hq, int dd) {
    const bf16* QKV = wsp<bf16>(c, OFF_QKV); const int hk = hq / SWA_G; const float sink = c.in[I_SWA_SINK][hq];
    const bf16* q = QKV + (size_t)row * SWA_N + hq * SWA_DH; const RowInfo ri = row_info(row);
    const int b = row < M_LAT ? row / SEQ : (row - M_LAT) / CTX;
    int k0 = 0, k1 = -1; if (row < M_LAT) { const int n = ri.t / SWA_BLK; k0 = (n - 1) * SWA_BLK; k1 = (n + 2) * SWA_BLK - 1; }
    float mx = sink;
    for (int kp = k0; kp <= k1; ++kp) { if (kp < 0 || kp >= SEQ || kp - ri.t > SWA_WIN || ri.t - kp > SWA_WIN) continue; const float s = swa_score(q, QKV + (size_t)(b * SEQ + kp) * SWA_N + SWA_NQ + hk * SWA_DH); mx = s > mx ? s : mx; }
    for (int kc = 0; kc < CTX; ++kc) { const float s = swa_score(q, QKV + (size_t)(M_LAT + b * CTX + kc) * SWA_N + SWA_NQ + hk * SWA_DH); mx = s > mx ? s : mx; }
    float l = expf(sink - mx), o = 0.f;
    for (int kp = k0; kp <= k1; ++kp) { if (kp < 0 || kp >= SEQ || kp - ri.t > SWA_WIN || ri.t - kp > SWA_WIN) continue; const bf16* kr = QKV + (size_t)(b * SEQ + kp) * SWA_N + SWA_NQ + hk * SWA_DH;
        const float pz = expf(swa_score(q, kr) - mx); l += pz; o += pz * bf2f(kr[SWA_NKV + dd]); }
    for (int kc = 0; kc < CTX; ++kc) { const bf16* kr = QKV + (size_t)(M_LAT + b * CTX + kc) * SWA_N + SWA_NQ + hk * SWA_DH;
        const float pz = expf(swa_score(q, kr) - mx); l += pz; o += pz * bf2f(kr[SWA_NKV + dd]); }
    return o / l;
}

DV void ph_moe_combine(const Ctx& c, int layer  , int nrows, int gtid, int gn) {
    float* XL = wsp<float>(c, OFF_XL); const bf16* YP = wsp<bf16>(c, OFF_YP); const int* SLOT = wsp<int>(c, OFF_SLOT); const float* TOPW = wsp<float>(c, OFF_TOPW);
    for (size_t idx = gtid; idx < (size_t)nrows * D_MODEL; idx += gn) {
        const int row = (int)(idx / D_MODEL), col = (int)(idx % D_MODEL); const RowInfo ri = row_info(row);
        const float y = TOPW[row * 2] * bf2f(YP[(size_t)SLOT[row * 2] * D_MODEL + col]) + TOPW[row * 2 + 1] * bf2f(YP[(size_t)SLOT[row * 2 + 1] * D_MODEL + col]);
        XL[idx] += modp(c, layer, ri.mrow, 5)[col] * y;
    }
}
HD unsigned atomic_add_u32(unsigned* p, unsigned v) {
#ifdef CPU_SHIM
    const unsigned o = *p; *p = o + v; return o;
#else
    return atomicAdd(p, v);
#endif
}
HD int moe_off(const unsigned* cnt, int e) { int o = 0;
#pragma unroll
    for (int x = 0; x < NEXP; ++x) if (x < e) o += ((int)cnt[x] + 255) / 256 * 256;
    return o; }
DV void ph_moe_perm(const Ctx& c, int f, int nrows, int gtid, int gn) {
    unsigned* ctl = wsp<unsigned>(c, OFF_CTL); const unsigned* cnt = ctl + CW_CNT + 64 * f; unsigned* cur = ctl + CW_CUR + 64 * f;
    const int* TOPI = wsp<int>(c, OFF_TOPI); int* SLOT = wsp<int>(c, OFF_SLOT); int* TILEE = wsp<int>(c, OFF_TILEE);
    for (int i = gtid; i < nrows * 2; i += gn) { const int e = TOPI[i]; SLOT[i] = moe_off(cnt, e) + (int)atomic_add_u32(cur + e, 1u); }
    const int ntile = moe_off(cnt, NEXP) / 256;
    for (int t = gtid; t < ntile; t += gn) { int e = 0, run = 0;
#pragma unroll
        for (int x = 0; x < NEXP - 1; ++x) { run += ((int)cnt[x] + 255) / 256 * 256; if (t * 256 >= run) e = x + 1; }
        TILEE[t] = e; }
}
DV void ph_moe_gather(const Ctx& c, int f, int nrows, int gtid, int gn) {
    const unsigned* cnt = wsp<unsigned>(c, OFF_CTL) + CW_CNT + 64 * f;
    const int* SLOT = wsp<int>(c, OFF_SLOT); const bf16* H = wsp<bf16>(c, OFF_H); bf16* AG = wsp<bf16>(c, OFF_AG);
    typedef unsigned u4 __attribute__((ext_vector_type(4))); constexpr int V = D_MODEL / 8;
    for (size_t idx = gtid; idx < (size_t)nrows * 2 * V; idx += gn) { const int i = (int)(idx / V), v = (int)(idx % V); ((u4*)(AG + (size_t)SLOT[i] * D_MODEL))[v] = ((const u4*)(H + (size_t)(i / 2) * D_MODEL))[v]; }
    for (size_t idx = gtid; idx < (size_t)NEXP * 256 * V; idx += gn) { const int e = (int)(idx / (256 * V)), r = (int)((idx / V) % 256), v = (int)(idx % V); const int s = moe_off(cnt, e) + (int)cnt[e] + r;
        if (s < moe_off(cnt, e + 1)) ((u4*)(AG + (size_t)s * D_MODEL))[v] = (u4){0u, 0u, 0u, 0u}; }
}

#ifndef CPU_SHIM
#define LAS __attribute__((address_space(3)))
typedef short bf16x8 __attribute__((ext_vector_type(8)));
typedef float f32x4 __attribute__((ext_vector_type(4)));
typedef float f32x2 __attribute__((ext_vector_type(2)));
typedef unsigned u32x4 __attribute__((ext_vector_type(4)));
typedef unsigned u32x2 __attribute__((ext_vector_type(2)));
constexpr int NTHREADS = 512, NWAVES = 8;
DV unsigned cvt_pk_bf16(float lo, float hi) { unsigned r; asm volatile("v_cvt_pk_bf16_f32 %0, %1, %2" : "=v"(r) : "v"(lo), "v"(hi)); return r; }
DV float wave_sum(float v) {
#pragma unroll
    for (int o = 1; o < 64; o <<= 1) v += __shfl_xor(v, o);
    return v;
}

namespace pg8 {
constexpr int BM = 256, BK = 64, HALF = 128, HTB = HALF * BK * 2, STAGE_BYTES = 8 * HTB, NXCD = 8, WGM = 8;
HD int lds_byte(int r, int c) { const int st = (r >> 4) * 2 + (c >> 5), rr = r & 15, cc = c & 31, ob = rr * 64 + cc * 2; return st * 1024 + (ob ^ (((ob >> 9) & 1) << 5)); }
HD void stage_rc(int b, int& R, int& C) { const int st = b / 1024, sb = b % 1024, swz = sb ^ (((sb >> 9) & 1) << 5); R = (st >> 1) * 16 + swz / 64; C = (st & 1) * 32 + (swz % 64) / 2; }
HD int perm32(int rho) { const int n = rho >> 4, i = rho & 15; return 8 * (i >> 2) + 4 * n + (i & 3); }
struct Unit { int pm, pn; const char* A; const char* B; };
struct Sched {
    int nM, nN, nwg, G, c;
    const char* A; size_t a_tile;
    int a_cmod; size_t a_cstep;
    const char* B; size_t b_tile;
    const int* tile_e; size_t b_exp;
    DV void init(int nM_, int nN_, int G_, int c_, const void* A_, size_t a_tile_, const void* B_, size_t b_tile_) {
        nM = nM_; nN = nN_; nwg = nM * nN; G = G_; c = c_; A = (const char*)A_; a_tile = a_tile_; a_cmod = 0; a_cstep = 0; B = (const char*)B_; b_tile = b_tile_; tile_e = nullptr; b_exp = 0; }
    DV bool next(int i, Unit& u) const {
        const long L = (long)i * G + c; if (L >= nwg) return false;
        int wgid = (int)L; { const int q = nwg / NXCD, r = nwg % NXCD, xcd = wgid % NXCD, off = wgid / NXCD; wgid = (xcd < r ? xcd * (q + 1) : r * (q + 1) + (xcd - r) * q) + off; }
        const int nig = WGM * nN, gid = wgid / nig, fm = gid * WGM, gsz = (nM - fm) < WGM ? (nM - fm) : WGM;
        u.pm = fm + ((wgid % nig) % gsz); u.pn = (wgid % nig) / gsz;
        u.A = A + (size_t)u.pm * a_tile + (a_cmod ? (size_t)(u.pn % a_cmod) * a_cstep : 0);
        u.B = B + (size_t)u.pn * b_tile + (tile_e ? (size_t)tile_e[u.pm] * b_exp : 0);
        return true;
    }
};
struct EpiBf16 {
    static constexpr bool PERM = true;
    bf16* O; size_t ldc;
    DV void operator()(const f32x4 (&acc)[2][2][4][2], const Unit& u, int wr, int wc, int fr, int fq) const {
        const int row0 = u.pm * BM + wr * 64 + fr, col0 = u.pn * BM + wc * 32 + 8 * fq;
#pragma unroll
        for (int ai = 0; ai < 2; ++ai)
#pragma unroll
            for (int m = 0; m < 4; ++m) { bf16* rowp = O + (size_t)(row0 + ai * HALF + m * 16) * ldc + col0;
#pragma unroll
                for (int bj = 0; bj < 2; ++bj) { const f32x4 v0 = acc[ai][bj][m][0], v1 = acc[ai][bj][m][1];
                    u32x4 w; w.x = cvt_pk_bf16(v0[0], v0[1]); w.y = cvt_pk_bf16(v0[2], v0[3]); w.z = cvt_pk_bf16(v1[0], v1[1]); w.w = cvt_pk_bf16(v1[2], v1[3]);
                    *(u32x4*)(rowp + bj * HALF) = w; } }
    }
};
struct EpiSwiglu {
    static constexpr bool PERM = true;
    bf16* O; size_t ldc;
    DV void operator()(const f32x4 (&acc)[2][2][4][2], const Unit& u, int wr, int wc, int fr, int fq) const {
        const int row0 = u.pm * BM + wr * 64 + fr, col0 = u.pn * HALF + wc * 32 + 8 * fq;
#pragma unroll
        for (int ai = 0; ai < 2; ++ai)
#pragma unroll
            for (int m = 0; m < 4; ++m) { bf16* rowp = O + (size_t)(row0 + ai * HALF + m * 16) * ldc + col0;
                float h[8];
#pragma unroll
                for (int n = 0; n < 2; ++n)
#pragma unroll
                    for (int x = 0; x < 4; ++x) { const float g = acc[ai][0][m][n][x], uu = acc[ai][1][m][n][x]; h[n * 4 + x] = g * __builtin_amdgcn_rcpf(1.0f + __expf(-g)) * uu; }
                u32x4 w; w.x = cvt_pk_bf16(h[0], h[1]); w.y = cvt_pk_bf16(h[2], h[3]); w.z = cvt_pk_bf16(h[4], h[5]); w.w = cvt_pk_bf16(h[6], h[7]);
                *(u32x4*)rowp = w; }
    }
};
struct EpiResid {
    static constexpr bool PERM = false;
    float* X; size_t ldc; const float* gate; size_t gstride;
    DV void operator()(const f32x4 (&acc)[2][2][4][2], const Unit& u, int wr, int wc, int fr, int fq) const {
        const int row0 = u.pm * BM + wr * 64 + fr, col0 = u.pn * BM + wc * 32 + 4 * fq;
        const int r0 = u.pm * BM; const int mrow = r0 < M_LAT ? r0 / SEQ : BATCH;
        const float* gp = gate + (size_t)mrow * gstride + col0;
        f32x4 gv[2][2];
#pragma unroll
        for (int bj = 0; bj < 2; ++bj)
#pragma unroll
            for (int n = 0; n < 2; ++n) gv[bj][n] = *(const f32x4*)(gp + bj * HALF + n * 16);
#pragma unroll
        for (int ai = 0; ai < 2; ++ai)
#pragma unroll
            for (int m = 0; m < 4; ++m) { float* rowp = X + (size_t)(row0 + ai * HALF + m * 16) * ldc + col0;
#pragma unroll
                for (int bj = 0; bj < 2; ++bj)
#pragma unroll
                    for (int n = 0; n < 2; ++n) { f32x4* p = (f32x4*)(rowp + bj * HALF + n * 16); *p = *p + gv[bj][n] * acc[ai][bj][m][n]; } }
    }
};

template <class Epi>
DV void gemm_phase(LAS unsigned char* lds, const int K, const int lda, const int ldb, const Sched& S, const Epi& E) {
    int tid = threadIdx.x; asm volatile("" : "+v"(tid));
    const int wid = __builtin_amdgcn_readfirstlane(tid >> 6), lane = tid & 63, wr = wid >> 2, wc = wid & 3, fr = lane & 15, fq = lane >> 4;
    const int nt = K / BK;
    unsigned voffA[2], voffB[2];
#pragma unroll
    for (int i = 0; i < 2; ++i) { int R, C; stage_rc(tid * 16 + i * 8192, R, C); const int Rb = Epi::PERM ? ((R & ~31) + perm32(R & 31)) : R;
        voffA[i] = (unsigned)(R * lda + C) * 2u; voffB[i] = (unsigned)(Rb * ldb + C) * 2u; }
    const size_t kstep = (size_t)(BK * 2);
    const size_t hstepA = (size_t)HALF * lda * 2, hstepB = (size_t)HALF * ldb * 2;
    const unsigned ldsw = (unsigned)wid * 1024u;
    const int aoff = lds_byte(wr * 64 + fr, fq * 8), boff = lds_byte(wc * 32 + fr, fq * 8);
#define PG8_SA(b, h) (((b) * 2 + (h)) * HTB)
#define PG8_SB(b, h) ((4 + (b) * 2 + (h)) * HTB)
#define PG8_STAGE(bufoff, gbase, voff) do { _Pragma("unroll") for (int _i = 0; _i < 2; ++_i) \
        __builtin_amdgcn_global_load_lds((const unsigned*)((const char*)(gbase) + (voff)[_i]), (LAS unsigned*)(lds + (bufoff) + ldsw + _i * 8192), 16, 0, 0); } while (0)
#define PG8_LDA(dst, b, h) do { _Pragma("unroll") for (int m = 0; m < 4; ++m) _Pragma("unroll") for (int k = 0; k < 2; ++k) dst[m][k] = *(const LAS bf16x8*)(lds + PG8_SA(b, h) + aoff + m * 2048 + k * 1024); } while (0)
#define PG8_LDB(dst, b, h) do { _Pragma("unroll") for (int n = 0; n < 2; ++n) _Pragma("unroll") for (int k = 0; k < 2; ++k) dst[n][k] = *(const LAS bf16x8*)(lds + PG8_SB(b, h) + boff + n * 2048 + k * 1024); } while (0)
#define PG8_MMA(ai, bj, At, Bt) do { __builtin_amdgcn_s_setprio(1); _Pragma("unroll") for (int m = 0; m < 4; ++m) _Pragma("unroll") for (int n = 0; n < 2; ++n) _Pragma("unroll") for (int k = 0; k < 2; ++k) \
        acc[ai][bj][m][n] = __builtin_amdgcn_mfma_f32_16x16x32_bf16(Bt[n][k], At[m][k], acc[ai][bj][m][n], 0, 0, 0); __builtin_amdgcn_s_setprio(0); } while (0)
#define PG8_WAIT_V(n) asm volatile("s_waitcnt vmcnt(" #n ")" ::: "memory")
#define PG8_WAIT_L(n) asm volatile("s_waitcnt lgkmcnt(" #n ")" ::: "memory")
#define PG8_BAR __builtin_amdgcn_s_barrier()
#define PG8_SCHED __builtin_amdgcn_sched_barrier(0)
    Unit cur, nxt; int ui = 0;
    if (!S.next(0, cur)) return;
    f32x4 acc[2][2][4][2];
#pragma unroll
    for (int a = 0; a < 2; ++a)
#pragma unroll
        for (int b = 0; b < 2; ++b)
#pragma unroll
            for (int m = 0; m < 4; ++m)
#pragma unroll
                for (int n = 0; n < 2; ++n) acc[a][b][m][n] = (f32x4){0.f, 0.f, 0.f, 0.f};
    bf16x8 At[4][2], B0[2][2], B1[2][2];
    const char* cA = cur.A; const char* cB = cur.B;
    PG8_STAGE(PG8_SB(0, 0), cB, voffB); PG8_STAGE(PG8_SB(0, 1), cB + hstepB, voffB); PG8_STAGE(PG8_SA(0, 0), cA, voffA); PG8_STAGE(PG8_SA(0, 1), cA + hstepA, voffA);
    if (wr == 1) PG8_BAR;
    PG8_WAIT_V(2); PG8_BAR;
    PG8_STAGE(PG8_SB(1, 0), cB + kstep, voffB); PG8_STAGE(PG8_SA(1, 0), cA + kstep, voffA); PG8_STAGE(PG8_SB(1, 1), cB + hstepB + kstep, voffB);
    PG8_WAIT_V(6); PG8_BAR;
    for (;;) {
        const bool has_next = S.next(ui + 1, nxt);
        const char* nA = has_next ? nxt.A : cA; const char* nB = has_next ? nxt.B : cB;
        for (int t = 0; t < nt; t += 2) {
            const bool last = (t == nt - 2);
            const char* a1 = cA + (size_t)(t + 1) * kstep;
            const char* a2 = last ? nA : cA + (size_t)(t + 2) * kstep; const char* b2 = last ? nB : cB + (size_t)(t + 2) * kstep;
            const char* a3 = a2 + kstep; const char* b3 = b2 + kstep;
            PG8_LDB(B0, 0, 0); PG8_LDB(B1, 0, 1); PG8_SCHED; PG8_LDA(At, 0, 0); PG8_STAGE(PG8_SA(1, 1), a1 + hstepA, voffA);
            PG8_WAIT_V(8); PG8_WAIT_L(0); PG8_BAR; PG8_MMA(0, 0, At, B0); PG8_MMA(0, 1, At, B1); PG8_BAR; PG8_SCHED;
            PG8_LDA(At, 0, 1); PG8_STAGE(PG8_SB(0, 0), b2, voffB); PG8_STAGE(PG8_SB(0, 1), b2 + hstepB, voffB); PG8_STAGE(PG8_SA(0, 0), a2, voffA);
            PG8_WAIT_V(8); PG8_WAIT_L(0); PG8_BAR; PG8_MMA(1, 0, At, B0); PG8_MMA(1, 1, At, B1); PG8_BAR; PG8_SCHED;
            PG8_LDB(B0, 1, 0); PG8_LDB(B1, 1, 1); PG8_SCHED; PG8_LDA(At, 1, 0); PG8_STAGE(PG8_SA(0, 1), a2 + hstepA, voffA);
            PG8_WAIT_V(8); PG8_WAIT_L(0); PG8_BAR; PG8_MMA(0, 0, At, B0); PG8_MMA(0, 1, At, B1); PG8_BAR; PG8_SCHED;
            PG8_LDA(At, 1, 1); PG8_STAGE(PG8_SB(1, 0), b3, voffB); PG8_STAGE(PG8_SB(1, 1), b3 + hstepB, voffB); PG8_STAGE(PG8_SA(1, 0), a3, voffA);
            PG8_WAIT_V(8); PG8_WAIT_L(0); PG8_BAR; PG8_MMA(1, 0, At, B0); PG8_MMA(1, 1, At, B1); PG8_BAR; PG8_SCHED;
        }
        if (wr == 0) PG8_BAR;
        E(acc, cur, wr, wc, fr, fq);
        if (!has_next) break;
#pragma unroll
        for (int a = 0; a < 2; ++a)
#pragma unroll
            for (int b = 0; b < 2; ++b)
#pragma unroll
                for (int m = 0; m < 4; ++m)
#pragma unroll
                    for (int n = 0; n < 2; ++n) acc[a][b][m][n] = (f32x4){0.f, 0.f, 0.f, 0.f};
        cur = nxt; cA = nA; cB = nB; ++ui;
        if (wr == 1) PG8_BAR;
    }
    PG8_WAIT_V(0);
    PG8_BAR;
#undef PG8_SA
#undef PG8_SB
#undef PG8_STAGE
#undef PG8_LDA
#undef PG8_LDB
#undef PG8_MMA
#undef PG8_WAIT_V
#undef PG8_WAIT_L
#undef PG8_BAR
#undef PG8_SCHED
}
}

#define XB_TMO      128
#define XB_XCNT(j)  (256  + 64 * (j))
#define XB_XSUB(j)  (1280 + 64 * (j))
#define XB_XGEN(j)  (2304 + 64 * (j))
#define XB_TOP      3328
#define XB_TOPGEN   3392
#define XCD_BAR_WORDS 3456
#define XB_SPIN_CAP (1u << 24)
__device__ __forceinline__ unsigned xb_ld(unsigned* p)              { return __hip_atomic_load(p, __ATOMIC_RELAXED, __HIP_MEMORY_SCOPE_AGENT); }
__device__ __forceinline__ unsigned xb_add(unsigned* p, unsigned v) { return __hip_atomic_fetch_add(p, v, __ATOMIC_RELAXED, __HIP_MEMORY_SCOPE_AGENT); }
__device__ __forceinline__ unsigned xb_xcc_id() { return (unsigned)__builtin_amdgcn_s_getreg((3 << 11) | 20) & 0xFu; }
#define XB_SPIN(cond, bar) do { unsigned _sp = 0; while (cond) { __builtin_amdgcn_s_sleep(1); \
    if ((++_sp & 255u) == 0u) { if (xb_ld(&(bar)[XB_TMO])) break; if (_sp > XB_SPIN_CAP) { atomicAdd(&(bar)[XB_TMO], 1u); break; } } } } while (0)
struct XcdBarrier { unsigned* bar; unsigned x; volatile LAS unsigned* st; };
__device__ __forceinline__ XcdBarrier xcd_barrier_post(unsigned* bar, volatile LAS unsigned* st) {
    XcdBarrier b; b.bar = bar; b.x = xb_xcc_id(); b.st = st;
    if (threadIdx.x == 0) (void)xb_add(&bar[XB_XCNT(b.x)], 1u);
    return b;
}
__device__ __forceinline__ void xcd_barrier_complete(unsigned* bar, unsigned x, unsigned& nloc, unsigned& nx) {
    const unsigned G = gridDim.x * gridDim.y * gridDim.z;
    unsigned sum, cnt, mine, sp = 0u;
    for (;;) {
        sum = 0u; cnt = 0u; mine = 0u;
#pragma unroll
        for (unsigned j = 0; j < 16; ++j) { const unsigned c = xb_ld(&bar[XB_XCNT(j)]); sum += c; cnt += (c > 0u) ? 1u : 0u; mine = (j == x) ? c : mine; }
        if (sum == G) break;
        __builtin_amdgcn_s_sleep(1);
        if ((++sp & 255u) == 0u) { if (xb_ld(&bar[XB_TMO])) break; if (sp > XB_SPIN_CAP) { atomicAdd(&bar[XB_TMO], 1u); break; } }
    }
    nloc = mine > 0u ? mine : 1u; nx = cnt > 0u ? cnt : 1u;
}
__device__ __forceinline__ void xcd_barrier(const XcdBarrier& b) {
    asm volatile("s_waitcnt vmcnt(0)" ::: "memory");
    __syncthreads();
    if (threadIdx.x == 0) {
        unsigned* bar = b.bar;
        __builtin_amdgcn_s_waitcnt(0);
        unsigned nloc = b.st[0], nx = b.st[1];
        if (nloc == 0u) { xcd_barrier_complete(bar, b.x, nloc, nx); b.st[0] = nloc; b.st[1] = nx; }
        const unsigned old = xb_add(&bar[XB_XSUB(b.x)], 1u);
        const unsigned gen = old / nloc;
        if (old + 1u == (gen + 1u) * nloc) {
            __builtin_amdgcn_fence(__ATOMIC_RELEASE, "agent");
            asm volatile("s_waitcnt vmcnt(0)" ::: "memory");
            const unsigned og = xb_add(&bar[XB_TOP], 1u);
            const unsigned tg = og / nx;
            if (og + 1u == (tg + 1u) * nx) xb_add(&bar[XB_TOPGEN], 1u);
            else XB_SPIN(xb_ld(&bar[XB_TOPGEN]) == tg, bar);
            __builtin_amdgcn_fence(__ATOMIC_ACQUIRE, "agent");
            xb_add(&bar[XB_XGEN(b.x)], 1u);
            asm volatile("s_waitcnt vmcnt(0)" ::: "memory");
        } else {
            XB_SPIN(xb_ld(&bar[XB_XGEN(b.x)]) == gen, bar);
            __builtin_amdgcn_fence(__ATOMIC_ACQUIRE, "agent");
            asm volatile("s_waitcnt vmcnt(0)" ::: "memory");
        }
    }
    __syncthreads();
}

DV void conv_item(const float* W, int ldw, int srccol0, bf16* WT, int K, int destrow0, int k0, LAS float* scr, int lane) {
#pragma unroll 8
    for (int i = 0; i < 32; ++i) { const int kk = 2 * i + (lane >> 5); scr[kk * 33 + (lane & 31)] = W[(size_t)(k0 + kk) * ldw + srccol0 + (lane & 31)]; }
    asm volatile("s_waitcnt lgkmcnt(0)" ::: "memory");
    const int cch = lane & 7;
#pragma unroll
    for (int j = 0; j < 4; ++j) { const int n = (lane >> 3) + 8 * j; const LAS float* s = scr + (8 * cch) * 33 + n;
        u32x4 o; o.x = cvt_pk_bf16(s[0 * 33], s[1 * 33]); o.y = cvt_pk_bf16(s[2 * 33], s[3 * 33]); o.z = cvt_pk_bf16(s[4 * 33], s[5 * 33]); o.w = cvt_pk_bf16(s[6 * 33], s[7 * 33]);
        *(u32x4*)(WT + (size_t)(destrow0 + n) * K + k0 + 8 * cch) = o; }
    asm volatile("s_waitcnt lgkmcnt(0)" ::: "memory");
}
DV int conv_srccol(int mapkind, int coloff, int n0) {
    if (mapkind == 1) return n0 < 2 * RET_DKT ? n0 : n0 + RET_DVT;
    if (mapkind == 2) { const int pn = n0 / 256, s = (n0 % 256) / 128, c0 = n0 % 128; return s * D_FF + 128 * pn + c0; }
    return n0 + coloff;
}
DV void conv_job(const float* W, int ldw, int K, int N, bf16* WT, int mapkind, int coloff, long& base, LAS float* scr, int gw, int ngw, int lane) {
    const int nblk = N / 32, nitems = (K / 64) * nblk;
    int it = (int)(((long)gw - base) % ngw); if (it < 0) it += ngw;
    for (; it < nitems; it += ngw) { const int kb = it / nblk, nb = it % nblk; conv_item(W, ldw, conv_srccol(mapkind, coloff, nb * 32), WT, K, nb * 32, kb * 64, scr, lane); }
    base += nitems;
}
DV void ph_convert(const Ctx& c, LAS unsigned char* lds, int gw, int ngw, int lane, int wave, int gtid, int gn) {
    LAS float* scr = (LAS float*)(lds + wave * 8704);
    long base = 0;
    for (int j = 0; j < 2; ++j) {
        conv_job(c.in[I_LRU_WIN] + (size_t)j * D_MODEL * 2 * LRU_W, 2 * LRU_W, D_MODEL, 2 * LRU_W, (bf16*)(c.ws + OFF_W_LRU_IN + j * SZ_W_LRU_IN), 0, 0, base, scr, gw, ngw, lane);
        conv_job(c.in[I_LRU_WOUT] + (size_t)j * LRU_W * D_MODEL, D_MODEL, LRU_W, D_MODEL, (bf16*)(c.ws + OFF_W_LRU_OUT + j * SZ_W_LRU_OUT), 0, 0, base, scr, gw, ngw, lane);
        conv_job(c.in[I_FFN_GU] + (size_t)j * D_MODEL * 2 * D_FF, 2 * D_FF, D_MODEL, 2 * D_FF, (bf16*)(c.ws + OFF_W_FFN_GU + j * SZ_W_GU), 2, 0, base, scr, gw, ngw, lane);
        conv_job(c.in[I_FFN_DN] + (size_t)j * D_FF * D_MODEL, D_MODEL, D_FF, D_MODEL, (bf16*)(c.ws + OFF_W_FFN_DN + j * SZ_W_DN), 0, 0, base, scr, gw, ngw, lane);
    }
    conv_job(c.in[I_RET_WIN], 2 * RET_DKT + 2 * RET_DVT, D_MODEL, RET_NQKG, (bf16*)(c.ws + OFF_W_RET_A), 1, 0, base, scr, gw, ngw, lane);
    conv_job(c.in[I_RET_WIN], 2 * RET_DKT + 2 * RET_DVT, D_MODEL, RET_NKV, (bf16*)(c.ws + OFF_W_RET_B), 0, RET_DKT, base, scr, gw, ngw, lane);
    conv_job(c.in[I_RET_WOUT], D_MODEL, RET_DVT, D_MODEL, (bf16*)(c.ws + OFF_W_RET_OUT), 0, 0, base, scr, gw, ngw, lane);
    conv_job(c.in[I_SWA_WIN], SWA_N, D_MODEL, SWA_N, (bf16*)(c.ws + OFF_W_SWA_IN), 0, 0, base, scr, gw, ngw, lane);
    conv_job(c.in[I_SWA_WOUT], D_MODEL, SWA_NQ, D_MODEL, (bf16*)(c.ws + OFF_W_SWA_OUT), 0, 0, base, scr, gw, ngw, lane);
    for (int fe = 0; fe < 2 * NEXP; ++fe) {
        conv_job(c.in[I_MOE_GU] + (size_t)fe * D_MODEL * 2 * D_FF, 2 * D_FF, D_MODEL, 2 * D_FF, (bf16*)(c.ws + OFF_W_MOE_GU + fe * SZ_W_GU), 2, 0, base, scr, gw, ngw, lane);
        conv_job(c.in[I_MOE_DN] + (size_t)fe * D_FF * D_MODEL, D_MODEL, D_FF, D_MODEL, (bf16*)(c.ws + OFF_W_MOE_DN + fe * SZ_W_DN), 0, 0, base, scr, gw, ngw, lane);
    }
    for (size_t idx = gtid; idx < (size_t)2 * 4 * LRU_W * 256; idx += gn) {
        const int cc = (int)(idx % 256), n = (int)((idx / 256) % (4 * LRU_W)), j = (int)(idx / ((size_t)256 * 4 * LRU_W));
        const int pn = n / 256, r = n % 256, q = pn / 5, p = pn % 5, blk = r / 128, k = r % 128, blk2 = cc / 128, jj = cc % 128;
        const float v = blk == blk2 ? c.in[I_LRU_WG][(((size_t)(j * 4 + q) * LRU_NB + 2 * p + blk) * LRU_BS + jj) * LRU_BS + k] : 0.f;
        ((bf16*)(c.ws + OFF_W_LRU_G + j * SZ_W_LRU_G))[(size_t)n * 256 + cc] = f2bf(v);
    }
}

template <int MODE, bool COMB>
DV void ph_norm_gpu(const Ctx& c, int layer, int which, int nrows, int comb_layer, int gw, int ngw, int lane) {
    float* XL = wsp<float>(c, OFF_XL); bf16* H = wsp<bf16>(c, OFF_H);
    for (int row = gw; row < nrows; row += ngw) {
        const int mrow = row < M_LAT ? row / SEQ : BATCH;
        f32x4* xr = (f32x4*)(XL + (size_t)row * D_MODEL) + lane; f32x4 v[4]; float ss = 0.f;
#pragma unroll
        for (int j = 0; j < 4; ++j) v[j] = xr[64 * j];
        if (COMB) {
            const int s0 = wsp<int>(c, OFF_SLOT)[row * 2], s1 = wsp<int>(c, OFF_SLOT)[row * 2 + 1]; const float w0 = wsp<float>(c, OFF_TOPW)[row * 2], w1 = wsp<float>(c, OFF_TOPW)[row * 2 + 1];
            const bf16* y0 = wsp<bf16>(c, OFF_YP) + (size_t)s0 * D_MODEL + 4 * lane; const bf16* y1 = wsp<bf16>(c, OFF_YP) + (size_t)s1 * D_MODEL + 4 * lane; const float* g5 = modp(c, comb_layer, mrow, 5) + 4 * lane;
#pragma unroll
            for (int j = 0; j < 4; ++j) { const u32x2 a = *(const u32x2*)(y0 + 256 * j), b = *(const u32x2*)(y1 + 256 * j); const f32x4 g = *(const f32x4*)(g5 + 256 * j);
                f32x4 y; y[0] = w0 * __uint_as_float(a.x << 16) + w1 * __uint_as_float(b.x << 16); y[1] = w0 * __uint_as_float(a.x & 0xffff0000u) + w1 * __uint_as_float(b.x & 0xffff0000u);
                y[2] = w0 * __uint_as_float(a.y << 16) + w1 * __uint_as_float(b.y << 16); y[3] = w0 * __uint_as_float(a.y & 0xffff0000u) + w1 * __uint_as_float(b.y & 0xffff0000u);
                v[j] = v[j] + g * y; xr[64 * j] = v[j]; }
        }
#pragma unroll
        for (int j = 0; j < 4; ++j) ss += (v[j][0] * v[j][0] + v[j][1] * v[j][1]) + (v[j][2] * v[j][2] + v[j][3] * v[j][3]);
        const float rstd = 1.0f / sqrtf(wave_sum(ss) * (1.0f / D_MODEL) + EPS);
        if (MODE == 2) {
#pragma unroll
            for (int j = 0; j < 4; ++j) { const f32x4 g = *(const f32x4*)(c.in[I_FINALG] + 4 * lane + 256 * j); *((f32x4*)(c.out + (size_t)row * D_MODEL) + lane + 64 * j) = v[j] * rstd * g; }
        } else {
            const float* gp = c.in[I_NORMG] + (layer * 2 + which) * D_MODEL + 4 * lane; const float* sh = modp(c, layer, mrow, which * 3) + 4 * lane; const float* sc = modp(c, layer, mrow, which * 3 + 1) + 4 * lane;
            float lg[NEXP];
#pragma unroll
            for (int e = 0; e < NEXP; ++e) lg[e] = 0.f;
#pragma unroll
            for (int j = 0; j < 4; ++j) { const f32x4 g = *(const f32x4*)(gp + 256 * j), s1 = *(const f32x4*)(sc + 256 * j), s0 = *(const f32x4*)(sh + 256 * j);
                const f32x4 y = v[j] * rstd * g * (s1 + 1.0f) + s0;
                u32x2 w; w.x = cvt_pk_bf16(y[0], y[1]); w.y = cvt_pk_bf16(y[2], y[3]); *(u32x2*)(H + (size_t)row * D_MODEL + 4 * lane + 256 * j) = w;
                if (MODE == 1) { const float* rp = c.in[I_MOE_R] + ((size_t)(layer / 2) * D_MODEL + 4 * lane + 256 * j) * NEXP;
#pragma unroll
                    for (int x = 0; x < 4; ++x) { const f32x4 r0 = *(const f32x4*)(rp + x * NEXP), r1 = *(const f32x4*)(rp + x * NEXP + 4);
                        lg[0] += y[x] * r0[0]; lg[1] += y[x] * r0[1]; lg[2] += y[x] * r0[2]; lg[3] += y[x] * r0[3]; lg[4] += y[x] * r1[0]; lg[5] += y[x] * r1[1]; lg[6] += y[x] * r1[2]; lg[7] += y[x] * r1[3]; } } }
            if (MODE == 1) {
#pragma unroll
                for (int e = 0; e < NEXP; ++e) lg[e] = wave_sum(lg[e]);
                if (lane == 0) { int i0, i1; float w0, w1; top2(lg, i0, i1, w0, w1);
                    wsp<int>(c, OFF_TOPI)[row * 2] = i0; wsp<int>(c, OFF_TOPI)[row * 2 + 1] = i1; wsp<float>(c, OFF_TOPW)[row * 2] = w0; wsp<float>(c, OFF_TOPW)[row * 2 + 1] = w1;
                    unsigned* cnt = wsp<unsigned>(c, OFF_CTL) + CW_CNT + 64 * (layer / 2); atomicAdd(cnt + i0, 1u); atomicAdd(cnt + i1, 1u); }
            }
        }
    }
}
DV void ph_ret_comb_gpu(const Ctx& c, int gw, int ngw, int lane) {
    static_assert(RET_DV == 512, "lane mapping");
    for (int it = gw; it < M_ALL * RET_H; it += ngw) {
        const int row = it / RET_H, h = it % RET_H; const size_t o = (size_t)row * RET_DVT + h * RET_DV + 8 * lane;
        const u32x4 a = *(const u32x4*)(wsp<bf16>(c, OFF_OF) + o), b = *(const u32x4*)(wsp<bf16>(c, OFF_OB) + o), g = *(const u32x4*)(wsp<bf16>(c, OFF_QKG) + (size_t)row * RET_NQKG + 2 * RET_DKT + h * RET_DV + 8 * lane);
        float ov[8], gv[8]; float ss = 0.f;
#pragma unroll
        for (int x = 0; x < 4; ++x) { ov[2 * x] = __uint_as_float(a[x] << 16) + __uint_as_float(b[x] << 16); ov[2 * x + 1] = __uint_as_float(a[x] & 0xffff0000u) + __uint_as_float(b[x] & 0xffff0000u);
            gv[2 * x] = __uint_as_float(g[x] << 16); gv[2 * x + 1] = __uint_as_float(g[x] & 0xffff0000u); ss += ov[2 * x] * ov[2 * x] + ov[2 * x + 1] * ov[2 * x + 1]; }
        const float rn = 1.0f / sqrtf(wave_sum(ss) * (1.0f / RET_DV) + EPS); const float* gn = c.in[I_RET_GN] + h * RET_DV + 8 * lane;
        float r[8];
#pragma unroll
        for (int x = 0; x < 8; ++x) r[x] = siluf_(gv[x]) * (ov[x] * rn) * gn[x];
        u32x4 w; w.x = cvt_pk_bf16(r[0], r[1]); w.y = cvt_pk_bf16(r[2], r[3]); w.z = cvt_pk_bf16(r[4], r[5]); w.w = cvt_pk_bf16(r[6], r[7]);
        *(u32x4*)(wsp<bf16>(c, OFF_A3) + o) = w;
    }
}

constexpr int RT_C = 64, RT_QS = 264, RT_TS = 72;
constexpr int RT_Q = 0, RT_K = RT_Q + RT_C * RT_QS * 2, RT_KT = RT_K + RT_C * RT_QS * 2, RT_VT = RT_KT + RET_DK * RT_TS * 2, RT_P = RT_VT + 128 * RT_TS * 2, RT_END = RT_P + RT_C * RT_TS * 2;
DV u32x4 rev8(u32x4 v) { u32x4 o; o.x = (v.w >> 16) | (v.w << 16); o.y = (v.z >> 16) | (v.z << 16); o.z = (v.y >> 16) | (v.y << 16); o.w = (v.x >> 16) | (v.x << 16); return o; }
DV void ph_ret_gpu(const Ctx& c, LAS unsigned char* lds, int bid, int nb, int tid) {
    static_assert(RET_DK == 256 && RET_DV == 512, "retention kernel geometry");
    asm volatile("" : "+v"(tid));
    const bf16* QKG = wsp<bf16>(c, OFF_QKG); const bf16* KVT = wsp<bf16>(c, OFF_KVT);
    const int lane = tid & 63, w = __builtin_amdgcn_readfirstlane(tid >> 6), fr = lane & 15, fq = lane >> 4;
    for (int item = bid; item < BATCH * RET_H * 2 * 4; item += nb) {
        const int eq = item & 3, dir = (item >> 2) & 1, h = (item >> 3) % RET_H, b = item / (8 * RET_H);
        bf16* OUT = wsp<bf16>(c, dir ? OFF_OB : OFF_OF);
        const float lg = c.in[I_RET_LD][dir * RET_H + h], cdec = __expf(lg * (float)RT_C);
        float kdec[8];
#pragma unroll
        for (int x = 0; x < 8; ++x) kdec[x] = __expf(lg * (float)(RT_C - 1 - (8 * (tid & 7) + x)));
        f32x4 st[16];
#pragma unroll
        for (int x = 0; x < 16; ++x) st[x] = (f32x4){0.f, 0.f, 0.f, 0.f};
        constexpr int NSTEP = (CTX + SEQ) / RT_C, NSC = CTX / RT_C;
        for (int s = 0; s < NSTEP; ++s) {
            int rlo;
            if (s < NSC) rlo = M_LAT + b * CTX + (dir ? CTX - RT_C * (s + 1) : RT_C * s);
            else rlo = b * SEQ + (dir ? SEQ - RT_C * (s - NSC + 1) : RT_C * (s - NSC));
            __syncthreads();
#pragma unroll
            for (int x = 0; x < 4; ++x) { const int p = tid + 512 * x, i = p >> 5, cp = p & 31; const int row = dir ? rlo + RT_C - 1 - i : rlo + i;
                const bf16* src = QKG + (size_t)row * RET_NQKG + h * RET_DK + 8 * cp;
                *(LAS u32x4*)(lds + RT_Q + (i * RT_QS + 8 * cp) * 2) = *(const u32x4*)src;
                *(LAS u32x4*)(lds + RT_K + (i * RT_QS + 8 * cp) * 2) = *(const u32x4*)(src + RET_DKT); }
#pragma unroll
            for (int x = 0; x < 4; ++x) { const int p = tid + 512 * x, dd = p >> 3, jp = p & 7;
                u32x4 v = *(const u32x4*)(KVT + (size_t)(h * RET_DK + dd) * M_ALL + rlo + (dir ? RT_C - 8 - 8 * jp : 8 * jp)); if (dir) v = rev8(v);
                *(LAS u32x4*)(lds + RT_KT + (dd * RT_TS + 8 * jp) * 2) = v; }
#pragma unroll
            for (int x = 0; x < 2; ++x) { const int p = tid + 512 * x, e = p >> 3, jp = p & 7;
                u32x4 v = *(const u32x4*)(KVT + (size_t)(RET_DKT + h * RET_DV + 128 * eq + e) * M_ALL + rlo + (dir ? RT_C - 8 - 8 * jp : 8 * jp)); if (dir) v = rev8(v);
                u32x4 o;
#pragma unroll
                for (int y = 0; y < 4; ++y) o[y] = cvt_pk_bf16(__uint_as_float(v[y] << 16) * kdec[2 * y], __uint_as_float(v[y] & 0xffff0000u) * kdec[2 * y + 1]);
                *(LAS u32x4*)(lds + RT_VT + (e * RT_TS + 8 * jp) * 2) = o; }
            __syncthreads();
            { const int it = w >> 1, jt0 = 2 * (w & 1); f32x4 aS[2] = {(f32x4){0.f, 0.f, 0.f, 0.f}, (f32x4){0.f, 0.f, 0.f, 0.f}};
#pragma unroll
                for (int ks = 0; ks < 8; ++ks) { const bf16x8 a = *(const LAS bf16x8*)(lds + RT_Q + ((16 * it + fr) * RT_QS + 32 * ks + 8 * fq) * 2);
#pragma unroll
                    for (int jj = 0; jj < 2; ++jj) { const bf16x8 bb = *(const LAS bf16x8*)(lds + RT_K + ((16 * (jt0 + jj) + fr) * RT_QS + 32 * ks + 8 * fq) * 2); aS[jj] = __builtin_amdgcn_mfma_f32_16x16x32_bf16(a, bb, aS[jj], 0, 0, 0); } }
#pragma unroll
                for (int jj = 0; jj < 2; ++jj)
#pragma unroll
                    for (int r = 0; r < 4; ++r) { const int i = 16 * it + 4 * fq + r, j = 16 * (jt0 + jj) + fr; *(LAS bf16*)(lds + RT_P + (i * RT_TS + j) * 2) = f2bf(j <= i ? aS[jj][r] : 0.f); } }
            f32x4 aO[4];
#pragma unroll
            for (int it = 0; it < 4; ++it) aO[it] = (f32x4){0.f, 0.f, 0.f, 0.f};
#pragma unroll
            for (int ks = 0; ks < 8; ++ks) {
                u32x4 bp; bp.x = cvt_pk_bf16(st[2 * ks][0], st[2 * ks][1]); bp.y = cvt_pk_bf16(st[2 * ks][2], st[2 * ks][3]); bp.z = cvt_pk_bf16(st[2 * ks + 1][0], st[2 * ks + 1][1]); bp.w = cvt_pk_bf16(st[2 * ks + 1][2], st[2 * ks + 1][3]);
                const bf16x8 bb = __builtin_bit_cast(bf16x8, bp);
#pragma unroll
                for (int it = 0; it < 4; ++it) { const LAS unsigned char* qp = lds + RT_Q + ((16 * it + fr) * RT_QS + 32 * ks + 4 * fq) * 2;
                    const u32x2 lo = *(const LAS u32x2*)qp, hi = *(const LAS u32x2*)(qp + 32); u32x4 ap; ap.x = lo.x; ap.y = lo.y; ap.z = hi.x; ap.w = hi.y;
                    aO[it] = __builtin_amdgcn_mfma_f32_16x16x32_bf16(__builtin_bit_cast(bf16x8, ap), bb, aO[it], 0, 0, 0); } }
#pragma unroll
            for (int it = 0; it < 4; ++it) aO[it] = aO[it] * cdec;
            __syncthreads();
            bf16x8 vb[2];
#pragma unroll
            for (int ks = 0; ks < 2; ++ks) vb[ks] = *(const LAS bf16x8*)(lds + RT_VT + ((16 * w + fr) * RT_TS + 32 * ks + 8 * fq) * 2);
#pragma unroll
            for (int it = 0; it < 4; ++it)
#pragma unroll
                for (int ks = 0; ks < 2; ++ks) { const bf16x8 a = *(const LAS bf16x8*)(lds + RT_P + ((16 * it + fr) * RT_TS + 32 * ks + 8 * fq) * 2); aO[it] = __builtin_amdgcn_mfma_f32_16x16x32_bf16(a, vb[ks], aO[it], 0, 0, 0); }
#pragma unroll
            for (int it = 0; it < 4; ++it)
#pragma unroll
                for (int r = 0; r < 4; ++r) { const int i = 16 * it + 4 * fq + r; const int row = dir ? rlo + RT_C - 1 - i : rlo + i;
                    OUT[(size_t)row * RET_DVT + h * RET_DV + 128 * eq + 16 * w + fr] = f2bf(aO[it][r] * __expf(lg * (float)(i - (RT_C - 1)))); }
#pragma unroll
            for (int dt = 0; dt < 16; ++dt) { st[dt] = st[dt] * cdec;
#pragma unroll
                for (int ks = 0; ks < 2; ++ks) { const bf16x8 a = *(const LAS bf16x8*)(lds + RT_KT + ((16 * dt + fr) * RT_TS + 32 * ks + 8 * fq) * 2); st[dt] = __builtin_amdgcn_mfma_f32_16x16x32_bf16(a, vb[ks], st[dt], 0, 0, 0); } }
        }
    }
    __syncthreads();
}

DV void ph_swa_gpu(const Ctx& c, LAS unsigned char* lds, int bid, int nb, int tid) {
    static_assert(SWA_DH == 64 && SWA_G == 4, "swa kernel geometry");
    asm volatile("" : "+v"(tid));
    const bf16* QKV = wsp<bf16>(c, OFF_QKV); bf16* AO = wsp<bf16>(c, OFF_AO);
    LAS float* Ks = (LAS float*)lds; LAS float* Vs = Ks + 64 * 64;
    constexpr int NBLK = SEQ / SWA_BLK, NL = BATCH * SWA_HKV * NBLK, NU = NL + BATCH * SWA_HKV * (CTX / 128);
    for (int u = bid; u < NU; u += nb) {
        int b, hk, n; bool isctx = u >= NL;
        if (!isctx) { b = u / (SWA_HKV * NBLK); hk = (u / NBLK) % SWA_HKV; n = u % NBLK; } else { const int v = u - NL; b = v / (SWA_HKV * (CTX / 128)); hk = (v / (CTX / 128)) % SWA_HKV; n = v % (CTX / 128); }
        const int gh = tid >> 7, qi = tid & 127, hq = hk * SWA_G + gh, t = 128 * n + qi;
        const int row = isctx ? M_LAT + b * CTX + t : b * SEQ + t;
        float q[64], o[64];
        { const u32x4* qp = (const u32x4*)(QKV + (size_t)row * SWA_N + hq * SWA_DH);
#pragma unroll
            for (int x = 0; x < 8; ++x) { const u32x4 v = qp[x];
#pragma unroll
                for (int y = 0; y < 4; ++y) { q[8 * x + 2 * y] = __uint_as_float(v[y] << 16) * 0.125f; q[8 * x + 2 * y + 1] = __uint_as_float(v[y] & 0xffff0000u) * 0.125f; } } }
#pragma unroll
        for (int x = 0; x < 64; ++x) o[x] = 0.f;
        float m = c.in[I_SWA_SINK][hq], l = 1.0f;
        const int ntile = isctx ? CTX / 64 : 6 + CTX / 64;
        for (int tl = 0; tl < ntile; ++tl) {
            int krow0, kp0 = 0; bool band = false;
            if (!isctx && tl < 6) { kp0 = (n - 1) * SWA_BLK + 64 * tl; if (kp0 < 0 || kp0 >= SEQ) continue; krow0 = b * SEQ + kp0; band = true; }
            else krow0 = M_LAT + b * CTX + 64 * (isctx ? tl : tl - 6);
            __syncthreads();
            { const int key = tid >> 3, d8 = (tid & 7) * 8; const bf16* kp = QKV + (size_t)(krow0 + key) * SWA_N + SWA_NQ + hk * SWA_DH + d8;
                const u32x4 kv = *(const u32x4*)kp, vv = *(const u32x4*)(kp + SWA_NKV);
                f32x4 a0, a1, b0, b1;
                a0[0] = __uint_as_float(kv.x << 16); a0[1] = __uint_as_float(kv.x & 0xffff0000u); a0[2] = __uint_as_float(kv.y << 16); a0[3] = __uint_as_float(kv.y & 0xffff0000u);
                a1[0] = __uint_as_float(kv.z << 16); a1[1] = __uint_as_float(kv.z & 0xffff0000u); a1[2] = __uint_as_float(kv.w << 16); a1[3] = __uint_as_float(kv.w & 0xffff0000u);
                b0[0] = __uint_as_float(vv.x << 16); b0[1] = __uint_as_float(vv.x & 0xffff0000u); b0[2] = __uint_as_float(vv.y << 16); b0[3] = __uint_as_float(vv.y & 0xffff0000u);
                b1[0] = __uint_as_float(vv.z << 16); b1[1] = __uint_as_float(vv.z & 0xffff0000u); b1[2] = __uint_as_float(vv.w << 16); b1[3] = __uint_as_float(vv.w & 0xffff0000u);
                *(LAS f32x4*)(Ks + key * 64 + d8) = a0; *(LAS f32x4*)(Ks + key * 64 + d8 + 4) = a1; *(LAS f32x4*)(Vs + key * 64 + d8) = b0; *(LAS f32x4*)(Vs + key * 64 + d8 + 4) = b1; }
            __syncthreads();
            for (int kb = 0; kb < 8; ++kb) {
                float s[8]; float mx = m;
#pragma unroll
                for (int k8 = 0; k8 < 8; ++k8) { const LAS float* kr = Ks + (kb * 8 + k8) * 64; float a = 0.f;
#pragma unroll
                    for (int d = 0; d < 64; ++d) a += q[d] * kr[d];
                    if (band) { const int df = t - (kp0 + kb * 8 + k8); if (df > SWA_WIN || df < -SWA_WIN) a = -1.0e30f; }
                    s[k8] = a; mx = fmaxf(mx, a); }
                const float corr = __expf(m - mx); l *= corr;
#pragma unroll
                for (int d = 0; d < 64; ++d) o[d] *= corr;
#pragma unroll
                for (int k8 = 0; k8 < 8; ++k8) { const float p = __expf(s[k8] - mx); l += p; const LAS float* vr = Vs + (kb * 8 + k8) * 64;
#pragma unroll
                    for (int d = 0; d < 64; ++d) o[d] += p * vr[d]; }
                m = mx;
            }
        }
        const float il = 1.0f / l; u32x4* op = (u32x4*)(AO + (size_t)row * SWA_NQ + hq * SWA_DH);
#pragma unroll
        for (int x = 0; x < 8; ++x) { u32x4 w; w.x = cvt_pk_bf16(o[8 * x] * il, o[8 * x + 1] * il); w.y = cvt_pk_bf16(o[8 * x + 2] * il, o[8 * x + 3] * il); w.z = cvt_pk_bf16(o[8 * x + 4] * il, o[8 * x + 5] * il); w.w = cvt_pk_bf16(o[8 * x + 6] * il, o[8 * x + 7] * il); op[x] = w; }
    }
    __syncthreads();
}

#ifndef MK_CHECK
#define MK_CHECK 0
#endif
#ifndef MK_CHECK_TOL
#define MK_CHECK_TOL 0.03f
#endif
constexpr int CK_NS = 1024, CK_NID = 64;
constexpr size_t OFF_CKBUF = OFF_CTL + (512u << 10);
DV unsigned hash32(unsigned x) { x ^= x >> 16; x *= 0x7feb352dU; x ^= x >> 15; x *= 0x846ca68bU; x ^= x >> 16; return x; }
DV void ck_add(const Ctx& c, int id, float got, float ref) { float* a = (float*)(wsp<unsigned>(c, OFF_CTL) + CW_CHK) + 2 * id; const float d = got - ref; atomicAdd(a, d * d); atomicAdd(a + 1, ref * ref + 1e-12f); }
DV void ck_sample(int id, int s, int nrows, int ncols, int& row, int& col) { const unsigned h = hash32((unsigned)(id * 7919 + s) * 2654435761u + 12345u); row = (int)(h % (unsigned)nrows); col = (int)(hash32(h + 0x9e3779b9u) % (unsigned)ncols); }
template <class F> DV void ck_gemm_plain(const Ctx& c, int id, const bf16* A, int lda, const float* W, int ldw, int K, const bf16* O, size_t ldo, int nrows, int ncols, F srccol, int gtid) {
    if (gtid < CK_NS) { int row, n; ck_sample(id, gtid, nrows, ncols, row, n); ck_add(c, id, bf2f(O[(size_t)row * ldo + n]), spec_dot(A + (size_t)row * lda, W, ldw, K, srccol(n))); }
}
DV void ck_resid_pre(const Ctx& c, int id, int nrows, int gtid) { if (gtid < CK_NS) { int row, n; ck_sample(id, gtid, nrows, D_MODEL, row, n); wsp<float>(c, OFF_CKBUF)[id * CK_NS + gtid] = wsp<float>(c, OFF_XL)[(size_t)row * D_MODEL + n]; } }
DV void ck_resid_post(const Ctx& c, int id, int layer, int which, const bf16* A, int lda, const float* W, int K, int nrows, int gtid) {
    if (gtid < CK_NS) { int row, n; ck_sample(id, gtid, nrows, D_MODEL, row, n); const RowInfo ri = row_info(row);
        const float got = wsp<float>(c, OFF_XL)[(size_t)row * D_MODEL + n] - wsp<float>(c, OFF_CKBUF)[id * CK_NS + gtid];
        ck_add(c, id, got, modp(c, layer, ri.mrow, which)[n] * spec_dot(A + (size_t)row * lda, W, D_MODEL, K, n)); }
}
DV void ck_norm(const Ctx& c, int id, int layer, int which, int nrows, int gtid) {
    if (gtid < CK_NS) { int row, col; ck_sample(id, gtid, nrows, D_MODEL, row, col); const float rstd = spec_rstd(wsp<float>(c, OFF_XL) + (size_t)row * D_MODEL);
        ck_add(c, id, bf2f(wsp<bf16>(c, OFF_H)[(size_t)row * D_MODEL + col]), spec_norm(c, layer, which, row, col, rstd)); }
}
DV void ck_router(const Ctx& c, int id, int layer, int nrows, int gtid) {
    if (gtid < CK_NS) { int row, col; ck_sample(id, gtid, nrows, 1, row, col); const float rstd = spec_rstd(wsp<float>(c, OFF_XL) + (size_t)row * D_MODEL);
        float lg[NEXP];
#pragma unroll
        for (int e = 0; e < NEXP; ++e) lg[e] = 0.f;
        for (int k = 0; k < D_MODEL; ++k) { const float v = spec_norm(c, layer, 1, row, k, rstd); const float* rp = c.in[I_MOE_R] + ((size_t)(layer / 2) * D_MODEL + k) * NEXP;
#pragma unroll
            for (int e = 0; e < NEXP; ++e) lg[e] += v * rp[e]; }
        int i0, i1; float w0, w1; top2(lg, i0, i1, w0, w1);
        const int g0 = wsp<int>(c, OFF_TOPI)[row * 2], g1 = wsp<int>(c, OFF_TOPI)[row * 2 + 1];
        if (g0 == i0 && g1 == i1) { ck_add(c, id, wsp<float>(c, OFF_TOPW)[row * 2], w0); ck_add(c, id, wsp<float>(c, OFF_TOPW)[row * 2 + 1], w1); } else ck_add(c, id, 0.f, 1.f); }
}
DV void ck_swiglu(const Ctx& c, int id, const bf16* A, const float* W, const int* tile_e, size_t wexp, const bf16* O, int nrows, int gtid) {
    if (gtid < CK_NS) { int row, x; ck_sample(id, gtid, nrows, D_FF, row, x); const float* We = W + (tile_e ? (size_t)tile_e[row / 256] * wexp : 0);
        const float g = spec_dot(A + (size_t)row * D_MODEL, We, 2 * D_FF, D_MODEL, x), u = spec_dot(A + (size_t)row * D_MODEL, We, 2 * D_FF, D_MODEL, D_FF + x);
        ck_add(c, id, bf2f(O[(size_t)row * D_FF + x]), siluf_(g) * u); }
}
DV void ck_moe_dn(const Ctx& c, int id, const float* W, const int* tile_e, int nrows, int gtid) {
    if (gtid < CK_NS) { int row, n; ck_sample(id, gtid, nrows, D_MODEL, row, n); const float* We = W + (size_t)tile_e[row / 256] * D_FF * D_MODEL;
        ck_add(c, id, bf2f(wsp<bf16>(c, OFF_YP)[(size_t)row * D_MODEL + n]), spec_dot(wsp<bf16>(c, OFF_HIDM) + (size_t)row * D_FF, We, D_MODEL, D_FF, n)); }
}
DV void ck_gate(const Ctx& c, int id, int j, int gtid) { if (gtid < CK_NS) { int row, n; ck_sample(id, gtid, M_ALL, 4 * LRU_W, row, n); ck_add(c, id, bf2f(wsp<bf16>(c, OFF_GT)[(size_t)row * 4 * LRU_W + n]), spec_gate(c, j, row, n / LRU_W, n % LRU_W)); } }
DV void ck_ret(const Ctx& c, int id, int dir, int gtid) { if (gtid < 256) { int row, n; ck_sample(id, gtid, M_ALL, RET_DVT, row, n); ck_add(c, id, bf2f(wsp<bf16>(c, dir ? OFF_OB : OFF_OF)[(size_t)row * RET_DVT + n]), spec_ret(c, row, n / RET_DV, n % RET_DV, dir)); } }
DV void ck_kvt(const Ctx& c, int id, int gtid) { if (gtid < CK_NS) { int tok, r; ck_sample(id, gtid, M_ALL, RET_NKV, tok, r);
    ck_add(c, id, bf2f(wsp<bf16>(c, OFF_KVT)[(size_t)r * M_ALL + tok]), spec_dot(wsp<bf16>(c, OFF_H) + (size_t)tok * D_MODEL, c.in[I_RET_WIN], 2 * RET_DKT + 2 * RET_DVT, D_MODEL, RET_DKT + r)); } }
DV void ck_retcomb(const Ctx& c, int id, int gtid) { if (gtid < CK_NS) { int row, n; ck_sample(id, gtid, M_ALL, RET_DVT, row, n); ck_add(c, id, bf2f(wsp<bf16>(c, OFF_A3)[(size_t)row * RET_DVT + n]), spec_ret_comb(c, row, n / RET_DV, n % RET_DV)); } }
DV void ck_swa(const Ctx& c, int id, int gtid) { if (gtid < CK_NS) { int row, n; ck_sample(id, gtid, M_ALL, SWA_NQ, row, n); ck_add(c, id, bf2f(wsp<bf16>(c, OFF_AO)[(size_t)row * SWA_NQ + n]), spec_swa(c, row, n / SWA_DH, n % SWA_DH)); } }

constexpr int LDS_BYTES = 147456, MISC_OFF = 143360;
static_assert(RT_END <= MISC_OFF && pg8::STAGE_BYTES <= MISC_OFF, "LDS map");

__global__ void __launch_bounds__(NTHREADS, 2) hybrid_fwd(Ctx c) {
    extern __shared__ __attribute__((aligned(16))) unsigned char lds_raw[];
    LAS unsigned char* lds = (LAS unsigned char*)lds_raw;
    const int tid = threadIdx.x, lane = tid & 63, wave = __builtin_amdgcn_readfirstlane(tid >> 6);
    const int G = gridDim.x, bid = blockIdx.x;
    const int gtid = bid * NTHREADS + tid, gn = G * NTHREADS, gw = bid * NWAVES + wave, ngw = G * NWAVES;
    volatile LAS unsigned* MISC = (volatile LAS unsigned*)(lds + MISC_OFF);
    if (tid < 64) MISC[tid] = 0u;
    __syncthreads();
    unsigned* ctl = wsp<unsigned>(c, OFF_CTL);
    XcdBarrier bar = xcd_barrier_post(ctl + CW_BAR, MISC + 8);
#define GRID_BAR() xcd_barrier(bar)
#if MK_CHECK
#define CK(...) do { __VA_ARGS__; GRID_BAR(); } while (0)
#else
#define CK(...) do { } while (0)
#endif
    const bf16* H = wsp<bf16>(c, OFF_H); float* XL = wsp<float>(c, OFF_XL);
    const size_t MODL = (size_t)NMOD * 6 * D_MODEL;

    ph_convert(c, lds, gw, ngw, lane, wave, gtid, gn);
    ph_mod(c, gtid, gn); ph_tables(c, gtid, gn); ph_copy_x(c, gtid, gn);
    GRID_BAR();

#define NORM1(L, COMBL) do { if ((COMBL) >= 0) ph_norm_gpu<0, true>(c, L, 0, M_ALL, COMBL, gw, ngw, lane); else ph_norm_gpu<0, false>(c, L, 0, M_ALL, 0, gw, ngw, lane); GRID_BAR(); CK(ck_norm(c, (L) * 12 + 0, L, 0, M_ALL, gtid)); } while (0)
#define GEMM_RESID(L, WHICH, Aoff, KK, Woff, NROWS, Wf32, CKID) do { \
        CK(ck_resid_pre(c, CKID, NROWS, gtid)); \
        pg8::Sched S; S.init((NROWS) / 256, D_MODEL / 256, G, bid, c.ws + (Aoff), (size_t)256 * (KK) * 2, c.ws + (Woff), (size_t)256 * (KK) * 2); \
        pg8::EpiResid E{XL, (size_t)D_MODEL, wsp<float>(c, OFF_MOD) + (size_t)(L) * MODL + (WHICH) * D_MODEL, (size_t)6 * D_MODEL}; \
        pg8::gemm_phase<pg8::EpiResid>(lds, KK, KK, KK, S, E); GRID_BAR(); \
        CK(ck_resid_post(c, CKID, L, WHICH, wsp<bf16>(c, Aoff), KK, Wf32, KK, NROWS, gtid)); } while (0)
#define FFN_DENSE(L, F, NROWS) do { \
        ph_norm_gpu<0, false>(c, L, 1, NROWS, 0, gw, ngw, lane); GRID_BAR(); CK(ck_norm(c, (L) * 12 + 7, L, 1, NROWS, gtid)); \
        { pg8::Sched S; S.init((NROWS) / 256, 2 * D_FF / 256, G, bid, c.ws + OFF_H, (size_t)256 * D_MODEL * 2, c.ws + OFF_W_FFN_GU + (F) * SZ_W_GU, (size_t)256 * D_MODEL * 2); \
          pg8::EpiSwiglu E{wsp<bf16>(c, OFF_HID), (size_t)D_FF}; pg8::gemm_phase<pg8::EpiSwiglu>(lds, D_MODEL, D_MODEL, D_MODEL, S, E); GRID_BAR(); } \
        CK(ck_swiglu(c, (L) * 12 + 9, H, c.in[I_FFN_GU] + (size_t)(F) * D_MODEL * 2 * D_FF, nullptr, 0, wsp<bf16>(c, OFF_HID), NROWS, gtid)); \
        GEMM_RESID(L, 5, OFF_HID, D_FF, OFF_W_FFN_DN + (F) * SZ_W_DN, NROWS, c.in[I_FFN_DN] + (size_t)(F) * D_FF * D_MODEL, (L) * 12 + 10); } while (0)
#define FFN_MOE(L, F, NROWS) do { \
        ph_norm_gpu<1, false>(c, L, 1, NROWS, 0, gw, ngw, lane); GRID_BAR(); CK(ck_norm(c, (L) * 12 + 7, L, 1, NROWS, gtid)); CK(ck_router(c, (L) * 12 + 8, L, NROWS, gtid)); \
        ph_moe_perm(c, F, NROWS, gtid, gn); GRID_BAR(); ph_moe_gather(c, F, NROWS, gtid, gn); GRID_BAR(); \
        const int ntile = moe_off(ctl + CW_CNT + 64 * (F), NEXP) / 256; \
        { pg8::Sched S; S.init(ntile, 2 * D_FF / 256, G, bid, c.ws + OFF_AG, (size_t)256 * D_MODEL * 2, c.ws + OFF_W_MOE_GU + (size_t)(F) * NEXP * SZ_W_GU, (size_t)256 * D_MODEL * 2); S.tile_e = wsp<int>(c, OFF_TILEE); S.b_exp = SZ_W_GU; \
          pg8::EpiSwiglu E{wsp<bf16>(c, OFF_HIDM), (size_t)D_FF}; pg8::gemm_phase<pg8::EpiSwiglu>(lds, D_MODEL, D_MODEL, D_MODEL, S, E); GRID_BAR(); } \
        CK(ck_swiglu(c, (L) * 12 + 9, wsp<bf16>(c, OFF_AG), c.in[I_MOE_GU] + (size_t)(F) * NEXP * D_MODEL * 2 * D_FF, wsp<int>(c, OFF_TILEE), (size_t)D_MODEL * 2 * D_FF, wsp<bf16>(c, OFF_HIDM), ntile * 256, gtid)); \
        { pg8::Sched S; S.init(ntile, D_MODEL / 256, G, bid, c.ws + OFF_HIDM, (size_t)256 * D_FF * 2, c.ws + OFF_W_MOE_DN + (size_t)(F) * NEXP * SZ_W_DN, (size_t)256 * D_FF * 2); S.tile_e = wsp<int>(c, OFF_TILEE); S.b_exp = SZ_W_DN; \
          pg8::EpiBf16 E{wsp<bf16>(c, OFF_YP), (size_t)D_MODEL}; pg8::gemm_phase<pg8::EpiBf16>(lds, D_FF, D_FF, D_FF, S, E); GRID_BAR(); } \
        CK(ck_moe_dn(c, (L) * 12 + 10, c.in[I_MOE_DN] + (size_t)(F) * NEXP * D_FF * D_MODEL, wsp<int>(c, OFF_TILEE), ntile * 256, gtid)); } while (0)
#define MIX_LRU(L, J, NROWS_OUT) do { \
        { pg8::Sched S; S.init(M_ALL / 256, 2 * LRU_W / 256, G, bid, c.ws + OFF_H, (size_t)256 * D_MODEL * 2, c.ws + OFF_W_LRU_IN + (J) * SZ_W_LRU_IN, (size_t)256 * D_MODEL * 2); \
          pg8::EpiBf16 E{wsp<bf16>(c, OFF_Y1), (size_t)2 * LRU_W}; pg8::gemm_phase<pg8::EpiBf16>(lds, D_MODEL, D_MODEL, D_MODEL, S, E); GRID_BAR(); } \
        CK(ck_gemm_plain(c, (L) * 12 + 1, H, D_MODEL, c.in[I_LRU_WIN] + (size_t)(J) * D_MODEL * 2 * LRU_W, 2 * LRU_W, D_MODEL, wsp<bf16>(c, OFF_Y1), (size_t)2 * LRU_W, M_ALL, 2 * LRU_W, [](int n) { return n; }, gtid)); \
        ph_conv(c, J, gtid, gn); GRID_BAR(); \
        { pg8::Sched S; S.init(M_ALL / 256, 4 * LRU_W / 256, G, bid, c.ws + OFF_U, (size_t)256 * LRU_W * 2, c.ws + OFF_W_LRU_G + (J) * SZ_W_LRU_G, (size_t)256 * 256 * 2); S.a_cmod = 5; S.a_cstep = 256 * 2; \
          pg8::EpiBf16 E{wsp<bf16>(c, OFF_GT), (size_t)4 * LRU_W}; pg8::gemm_phase<pg8::EpiBf16>(lds, 256, LRU_W, 256, S, E); GRID_BAR(); } \
        CK(ck_gate(c, (L) * 12 + 2, J, gtid)); \
        ph_scan1(c, J, gtid, gn); GRID_BAR(); ph_scan2(c, gtid, gn); GRID_BAR(); ph_scan3(c, J, gtid, gn); GRID_BAR(); \
        GEMM_RESID(L, 2, OFF_A2, LRU_W, OFF_W_LRU_OUT + (J) * SZ_W_LRU_OUT, NROWS_OUT, c.in[I_LRU_WOUT] + (size_t)(J) * LRU_W * D_MODEL, (L) * 12 + 6); } while (0)

#ifndef NO_L0
    NORM1(0, -1);
#ifndef NO_L0M
    MIX_LRU(0, 0, M_ALL);
#endif
#ifndef NO_L0F
    FFN_DENSE(0, 0, M_ALL);
#endif
#endif
#ifndef NO_L1
    NORM1(1, -1);
    { pg8::Sched S; S.init(M_ALL / 256, RET_NQKG / 256, G, bid, c.ws + OFF_H, (size_t)256 * D_MODEL * 2, c.ws + OFF_W_RET_A, (size_t)256 * D_MODEL * 2);
      pg8::EpiBf16 E{wsp<bf16>(c, OFF_QKG), (size_t)RET_NQKG}; pg8::gemm_phase<pg8::EpiBf16>(lds, D_MODEL, D_MODEL, D_MODEL, S, E); }
    { pg8::Sched S; S.init(RET_NKV / 256, M_ALL / 256, G, bid, c.ws + OFF_W_RET_B, (size_t)256 * D_MODEL * 2, c.ws + OFF_H, (size_t)256 * D_MODEL * 2);
      pg8::EpiBf16 E{wsp<bf16>(c, OFF_KVT), (size_t)M_ALL}; pg8::gemm_phase<pg8::EpiBf16>(lds, D_MODEL, D_MODEL, D_MODEL, S, E); GRID_BAR(); }
    CK(ck_gemm_plain(c, 12 + 1, H, D_MODEL, c.in[I_RET_WIN], 2 * RET_DKT + 2 * RET_DVT, D_MODEL, wsp<bf16>(c, OFF_QKG), (size_t)RET_NQKG, M_ALL, RET_NQKG, [](int n) { return n < 2 * RET_DKT ? n : n + RET_DVT; }, gtid));
    CK(ck_kvt(c, 12 + 2, gtid));
    ph_ret_rope(c, gtid, gn); GRID_BAR();
#ifndef NO_RET
    ph_ret_gpu(c, lds, bid, G, tid);
#endif
    GRID_BAR();
    CK(ck_ret(c, 12 + 3, 0, gtid)); CK(ck_ret(c, 12 + 4, 1, gtid));
    ph_ret_comb_gpu(c, gw, ngw, lane); GRID_BAR();
    CK(ck_retcomb(c, 12 + 5, gtid));
    GEMM_RESID(1, 2, OFF_A3, RET_DVT, OFF_W_RET_OUT, M_ALL, c.in[I_RET_WOUT], 12 + 6);
#ifndef NO_L1F
    FFN_MOE(1, 0, M_ALL);
#endif
#endif
#ifndef NO_L2
    NORM1(2, 1);
    { pg8::Sched S; S.init(M_ALL / 256, SWA_N / 256, G, bid, c.ws + OFF_H, (size_t)256 * D_MODEL * 2, c.ws + OFF_W_SWA_IN, (size_t)256 * D_MODEL * 2);
      pg8::EpiBf16 E{wsp<bf16>(c, OFF_QKV), (size_t)SWA_N}; pg8::gemm_phase<pg8::EpiBf16>(lds, D_MODEL, D_MODEL, D_MODEL, S, E); GRID_BAR(); }
    CK(ck_gemm_plain(c, 24 + 1, H, D_MODEL, c.in[I_SWA_WIN], SWA_N, D_MODEL, wsp<bf16>(c, OFF_QKV), (size_t)SWA_N, M_ALL, SWA_N, [](int n) { return n; }, gtid));
    ph_swa_rope(c, gtid, gn); GRID_BAR();
#ifndef NO_SWA
    ph_swa_gpu(c, lds, bid, G, tid);
#endif
    GRID_BAR();
    CK(ck_swa(c, 24 + 3, gtid));
    GEMM_RESID(2, 2, OFF_AO, SWA_NQ, OFF_W_SWA_OUT, M_ALL, c.in[I_SWA_WOUT], 24 + 6);
    FFN_DENSE(2, 1, M_ALL);
#endif
#ifndef NO_L3
    NORM1(3, -1);
    MIX_LRU(3, 1, M_LAT);
    FFN_MOE(3, 1, M_LAT);
#endif
    ph_norm_gpu<2, true>(c, 3, 0, M_LAT, 3, gw, ngw, lane);
#if MK_CHECK
    GRID_BAR();
    { const float* a = (const float*)(ctl + CW_CHK); int bad = 0;
      for (int id = CK_NID - 1; id >= 0; --id) { const float sd = a[2 * id], sr = a[2 * id + 1]; if (sr > 0.f && sd > sr * (MK_CHECK_TOL * MK_CHECK_TOL)) bad = id + 1; }
      if (ctl[CW_BAR + XB_TMO]) bad = 80;
      if (bad) { const float v = sqrtf((float)bad); for (size_t i = gtid; i < (size_t)M_LAT * D_MODEL; i += gn) c.out[i] = v; } }
#endif
}

extern "C" void kernel_launch(void* const* d_in, const int* in_sizes, int n_in, void* d_out, int out_size, void* d_ws, size_t ws_size, hipStream_t stream) {
    static int grid = 0;
    if (grid == 0) {
        if (n_in != N_IN || out_size != M_LAT * D_MODEL || ws_size < WS_NEED) { fprintf(stderr, "kernel_launch: unexpected shapes (n_in %d, out %d, ws %zu, need %zu)\n", n_in, out_size, ws_size, (size_t)WS_NEED); grid = -1; return; }
        int dev = 0, cus = 0, per_cu = 0;
        if (hipGetDevice(&dev) != hipSuccess || hipDeviceGetAttribute(&cus, hipDeviceAttributeMultiprocessorCount, dev) != hipSuccess) { grid = -1; return; }
        if (hipFuncSetAttribute((const void*)hybrid_fwd, hipFuncAttributeMaxDynamicSharedMemorySize, LDS_BYTES) != hipSuccess) { fprintf(stderr, "kernel_launch: hipFuncSetAttribute failed\n"); grid = -1; return; }
        if (hipOccupancyMaxActiveBlocksPerMultiprocessor(&per_cu, (const void*)hybrid_fwd, NTHREADS, LDS_BYTES) != hipSuccess || per_cu < 1) fprintf(stderr, "kernel_launch: occupancy query says %d\n", per_cu);
        (void)hipGetLastError();
        grid = cus;
    }
    if (grid < 0) return;
    if (hipMemsetAsync((char*)d_ws + OFF_CTL, 0, SZ_CTL, stream) != hipSuccess) return;
    Ctx c{};
    for (int i = 0; i < N_IN; ++i) c.in[i] = (const float*)d_in[i];
    c.out = (float*)d_out; c.ws = (unsigned char*)d_ws;
    hipLaunchKernelGGL(hybrid_fwd, dim3(grid), dim3(NTHREADS), LDS_BYTES, stream, c);
}
#endif
```

```cpp
#ifndef CPU_SHIM
#include <hip/hip_runtime.h>
#include <cstdio>
#include <cstdint>
#define HD __host__ __device__ __forceinline__
#define DV __device__ __forceinline__
#else
#include <cmath>
#include <cstring>
#include <cstddef>
#include <cstdio>
#define HD inline
#define DV inline
#endif

#ifdef CFG_SMALL
constexpr int D_MODEL = 64, BATCH = 2, SEQ = 512, CTX = 256, LRU_NB = 3, LRU_BS = 16, RET_H = 2, RET_DK = 16, RET_DV = 32, SWA_HQ = 4, SWA_HKV = 2, SWA_DH = 16, D_FF = 96;
#else
constexpr int D_MODEL = 1024, BATCH = 8, SEQ = 4096, CTX = 256, LRU_NB = 10, LRU_BS = 128, RET_H = 4, RET_DK = 256, RET_DV = 512, SWA_HQ = 16, SWA_HKV = 4, SWA_DH = 64, D_FF = 3584;
#endif
constexpr int DEPTH = 4, GRID_W = 64, NEXP = 8, LRU_W = LRU_NB * LRU_BS, RET_DKT = RET_H * RET_DK, RET_DVT = RET_H * RET_DV;
constexpr int SCH = 128;
constexpr int SWA_BLK = 128, SWA_WIN = 128, SWA_G = SWA_HQ / SWA_HKV, SWA_NQ = SWA_HQ * SWA_DH, SWA_NKV = SWA_HKV * SWA_DH, SWA_N = SWA_NQ + 2 * SWA_NKV;
constexpr int M_LAT = BATCH * SEQ, M_CTX = BATCH * CTX, M_ALL = M_LAT + M_CTX, NMOD = BATCH + 1;
constexpr int NCHK = (CTX + SEQ) / SCH, NCHK_C = CTX / SCH;
constexpr int RET_NQKG = 2 * RET_DKT + RET_DVT, RET_NKV = RET_DKT + RET_DVT;
constexpr int MAXSLOT = 2 * M_ALL + NEXP * 256, MAXTILE = MAXSLOT / 256;
constexpr float EPS = 1e-6f;
enum { I_X = 0, I_C, I_CTX, I_CCTX, I_ADAW, I_ADAB, I_NORMG, I_FINALG, I_LRU_WIN, I_LRU_CW, I_LRU_CB, I_LRU_WG, I_LRU_BG, I_LRU_LAM, I_LRU_WOUT,
       I_RET_WIN, I_RET_LD, I_RET_GN, I_RET_WOUT, I_SWA_WIN, I_SWA_SINK, I_SWA_WOUT, I_FFN_GU, I_FFN_DN, I_MOE_R, I_MOE_GU, I_MOE_DN, N_IN };

constexpr size_t al256(size_t x) { return (x + 255) & ~size_t(255); }
constexpr size_t OFF_CTL = 0, SZ_CTL = 1u << 20;
constexpr size_t OFF_MOD = OFF_CTL + SZ_CTL;
constexpr size_t OFF_SP8 = OFF_MOD + al256((size_t)DEPTH * NMOD * 6 * D_MODEL * 4);
constexpr size_t OFF_RCOS = OFF_SP8 + al256((size_t)4 * LRU_W * 4);
constexpr size_t OFF_RSIN = OFF_RCOS + al256((size_t)SEQ * (RET_DK / 2) * 4);
constexpr size_t OFF_SCOS = OFF_RSIN + al256((size_t)SEQ * (RET_DK / 2) * 4);
constexpr size_t OFF_SSIN = OFF_SCOS + al256((size_t)SEQ * (SWA_DH / 2) * 4);
constexpr size_t OFF_TOPI = OFF_SSIN + al256((size_t)SEQ * (SWA_DH / 2) * 4);
constexpr size_t OFF_TOPW = OFF_TOPI + al256((size_t)M_ALL * 2 * 4);
constexpr size_t OFF_SLOT = OFF_TOPW + al256((size_t)M_ALL * 2 * 4);
constexpr size_t OFF_TILEE = OFF_SLOT + al256((size_t)M_ALL * 2 * 4);
constexpr size_t OFF_PSP = OFF_TILEE + al256((size_t)MAXTILE * 4);
constexpr size_t SZ_PS = al256((size_t)BATCH * 2 * NCHK * LRU_W * 4);
constexpr size_t OFF_PSS = OFF_PSP + SZ_PS, OFF_CIN = OFF_PSS + SZ_PS;
constexpr size_t OFF_WB = al256(OFF_CIN + SZ_PS);
constexpr size_t SZ_W_LRU_IN = (size_t)2 * LRU_W * D_MODEL * 2, SZ_W_LRU_G = (size_t)4 * LRU_W * 256 * 2, SZ_W_LRU_OUT = (size_t)D_MODEL * LRU_W * 2;
constexpr size_t OFF_W_LRU_IN = OFF_WB, OFF_W_LRU_G = OFF_W_LRU_IN + 2 * SZ_W_LRU_IN, OFF_W_LRU_OUT = OFF_W_LRU_G + 2 * SZ_W_LRU_G;
constexpr size_t OFF_W_RET_A = OFF_W_LRU_OUT + 2 * SZ_W_LRU_OUT;
constexpr size_t OFF_W_RET_B = OFF_W_RET_A + (size_t)RET_NQKG * D_MODEL * 2;
constexpr size_t OFF_W_RET_OUT = OFF_W_RET_B + (size_t)RET_NKV * D_MODEL * 2;
constexpr size_t OFF_W_SWA_IN = OFF_W_RET_OUT + (size_t)D_MODEL * RET_DVT * 2;
constexpr size_t OFF_W_SWA_OUT = OFF_W_SWA_IN + (size_t)SWA_N * D_MODEL * 2;
constexpr size_t SZ_W_GU = (size_t)2 * D_FF * D_MODEL * 2, SZ_W_DN = (size_t)D_MODEL * D_FF * 2;
constexpr size_t OFF_W_FFN_GU = OFF_W_SWA_OUT + (size_t)D_MODEL * SWA_NQ * 2, OFF_W_FFN_DN = OFF_W_FFN_GU + 2 * SZ_W_GU;
constexpr size_t OFF_W_MOE_GU = OFF_W_FFN_DN + 2 * SZ_W_DN, OFF_W_MOE_DN = OFF_W_MOE_GU + 2 * NEXP * SZ_W_GU;
constexpr size_t OFF_XL = al256(OFF_W_MOE_DN + 2 * NEXP * SZ_W_DN);
constexpr size_t OFF_H = OFF_XL + (size_t)M_ALL * D_MODEL * 4;
constexpr size_t OFF_DYN = al256(OFF_H + (size_t)M_ALL * D_MODEL * 2);
constexpr size_t OFF_Y1 = OFF_DYN;
constexpr size_t OFF_U = OFF_Y1 + (size_t)M_ALL * 2 * LRU_W * 2;
constexpr size_t OFF_GT = OFF_U + (size_t)M_ALL * LRU_W * 2;
constexpr size_t OFF_HL = OFF_GT + (size_t)M_ALL * 4 * LRU_W * 2;
constexpr size_t OFF_PC = OFF_HL + (size_t)2 * M_ALL * LRU_W * 2;
constexpr size_t OFF_A2 = OFF_PC + (size_t)2 * M_ALL * LRU_W * 2;
constexpr size_t END_LRU = OFF_A2 + (size_t)M_ALL * LRU_W * 2;
constexpr size_t OFF_QKG = OFF_DYN;
constexpr size_t OFF_KVT = OFF_QKG + (size_t)M_ALL * RET_NQKG * 2;
constexpr size_t OFF_OF = OFF_KVT + (size_t)RET_NKV * M_ALL * 2;
constexpr size_t OFF_OB = OFF_OF + (size_t)M_ALL * RET_DVT * 2;
constexpr size_t OFF_A3 = OFF_OB + (size_t)M_ALL * RET_DVT * 2;
constexpr size_t END_RET = OFF_A3 + (size_t)M_ALL * RET_DVT * 2;
constexpr size_t OFF_QKV = OFF_DYN;
constexpr size_t OFF_AO = OFF_QKV + (size_t)M_ALL * SWA_N * 2;
constexpr size_t END_SWA = OFF_AO + (size_t)M_ALL * SWA_NQ * 2;
constexpr size_t OFF_HID = OFF_DYN;
constexpr size_t END_FFN = OFF_HID + (size_t)M_ALL * D_FF * 2;
constexpr size_t OFF_YP = OFF_DYN;
constexpr size_t OFF_AG = OFF_YP + (size_t)MAXSLOT * D_MODEL * 2;
constexpr size_t OFF_HIDM = OFF_AG + (size_t)MAXSLOT * D_MODEL * 2;
constexpr size_t END_MOE = OFF_HIDM + (size_t)MAXSLOT * D_FF * 2;
constexpr size_t cmax(size_t a, size_t b) { return a > b ? a : b; }
constexpr size_t WS_NEED = cmax(cmax(END_LRU, END_RET), cmax(cmax(END_SWA, END_FFN), END_MOE));
constexpr int CW_CNT = 64;
constexpr int CW_CUR = 256;
constexpr int CW_CHK = 1024;
constexpr int CW_BAR = 8192;

struct Ctx { const float* in[N_IN]; float* out; unsigned char* ws; };
template <class T> HD T* wsp(const Ctx& c, size_t off) { return (T*)(c.ws + off); }

typedef unsigned short bf16;
HD float bf2f(bf16 b) { unsigned u = ((unsigned)b) << 16; float f; __builtin_memcpy(&f, &u, 4); return f; }
HD bf16 f2bf(float f) { unsigned u; __builtin_memcpy(&u, &f, 4); u += 0x7fffu + ((u >> 16) & 1u); return (bf16)(u >> 16); }
HD float bfr(float f) { return bf2f(f2bf(f)); }
#ifdef CPU_SHIM
#define FEXP(x) expf(x)
#define FRCP(x) (1.0f / (x))
#else
#define FEXP(x) __expf(x)
#define FRCP(x) __builtin_amdgcn_rcpf(x)
#endif
HD float sigmoidf_(float x) { return 1.0f / (1.0f + expf(-x)); }
HD float fsigmoid(float x) { return FRCP(1.0f + FEXP(-x)); }
HD float fgelu(float x) { return x * fsigmoid(1.5957691216057308f * (x + 0.044715f * x * x * x)); }
HD float neg_expm1_small(float x) { return -x * (1.0f + x * 0.5f * (1.0f + x * (1.0f / 3.0f) * (1.0f + x * 0.25f * (1.0f + x * 0.2f * (1.0f + x * (1.0f / 6.0f)))))); }
HD float siluf_(float x) { return x / (1.0f + expf(-x)); }
HD float geluf_(float x) { return 0.5f * x * (1.0f + tanhf(0.7978845608028654f * (x + 0.044715f * x * x * x))); }

struct RowInfo { int mrow, t, L, seq0; };
HD RowInfo row_info(int row) {
    RowInfo r;
    if (row < M_LAT) { const int b = row / SEQ; r.mrow = b; r.t = row % SEQ; r.L = SEQ; r.seq0 = b * SEQ; }
    else { const int q = row - M_LAT, b = q / CTX; r.mrow = BATCH; r.t = q % CTX; r.L = CTX; r.seq0 = M_LAT + b * CTX; }
    return r;
}
HD const float* modp(const Ctx& c, int layer, int mrow, int which) { return wsp<float>(c, OFF_MOD) + ((size_t)(layer * NMOD + mrow) * 6 + which) * D_MODEL; }

template <class CP> DV void ph_mod(const Ctx& c, CP cond, int gtid, int gn) {
    float* MOD = wsp<float>(c, OFF_MOD);
    const int N6 = 6 * D_MODEL;
    for (int idx = gtid; idx < DEPTH * N6; idx += gn) {
        const int l = idx / N6, j = idx % N6;
        float acc[NMOD];
#pragma unroll
        for (int r = 0; r < NMOD; ++r) acc[r] = 0.f;
#pragma unroll 4
        for (int k = 0; k < D_MODEL; ++k) {
            const float w = c.in[I_ADAW][((size_t)l * D_MODEL + k) * N6 + j];
#pragma unroll
            for (int r = 0; r < NMOD; ++r) acc[r] += cond[k * NMOD + r] * w;
        }
        const float b = c.in[I_ADAB][l * N6 + j];
#pragma unroll
        for (int r = 0; r < NMOD; ++r) MOD[((size_t)(l * NMOD + r)) * N6 + j] = acc[r] + b;
    }
}
template <class CP> DV void fill_cond(const Ctx& c, CP cond, int t0, int tn) {
    for (int i = t0; i < D_MODEL * NMOD; i += tn) { const int k = i / NMOD, r = i % NMOD; cond[i] = siluf_(r < BATCH ? c.in[I_C][r * D_MODEL + k] : c.in[I_CCTX][k]); }
}
DV void ph_tables(const Ctx& c, int gtid, int gn) {
    float* SP8 = wsp<float>(c, OFF_SP8);
    for (int i = gtid; i < 4 * LRU_W; i += gn) SP8[i] = (float)(8.0 * log1p(exp(-(double)c.in[I_LRU_LAM][i])));
    float* RC = wsp<float>(c, OFF_RCOS); float* RS = wsp<float>(c, OFF_RSIN);
    constexpr int NF = RET_DK / 2;
    for (int i = gtid; i < SEQ * NF; i += gn) {
        const int t = i / NF, f = i % NF; const double th = pow(10000.0, -(double)f / NF), a = (double)t * th;
        RC[i] = (float)cos(a); RS[i] = (float)sin(a);
    }
    float* SC = wsp<float>(c, OFF_SCOS); float* SS = wsp<float>(c, OFF_SSIN);
    constexpr int HF = SWA_DH / 2, QF = SWA_DH / 4;
    for (int i = gtid; i < SEQ * HF; i += gn) {
        const int t = i / HF, f = i % HF; const int pos = f < QF ? t / GRID_W : t % GRID_W;
        const double fr = pow(10000.0, -(double)(f % QF) / QF), a = (double)pos * fr;
        SC[i] = (float)cos(a); SS[i] = (float)sin(a);
    }
}
DV void ph_copy_x(const Ctx& c, int gtid, int gn) {
    float* XL = wsp<float>(c, OFF_XL);
    const size_t n4 = (size_t)M_ALL * D_MODEL / 4, nl4 = (size_t)M_LAT * D_MODEL / 4;
    typedef float f4 __attribute__((ext_vector_type(4)));
    for (size_t i = gtid; i < n4; i += gn) ((f4*)XL)[i] = i < nl4 ? ((const f4*)c.in[I_X])[i] : ((const f4*)c.in[I_CTX])[i - nl4];
}

HD float spec_rstd(const float* xr) { float ss = 0.f; for (int k = 0; k < D_MODEL; ++k) ss += xr[k] * xr[k]; return 1.0f / sqrtf(ss / D_MODEL + EPS); }
HD float spec_norm(const Ctx& c, int layer, int which, int row, int col, float rstd) {
    const RowInfo ri = row_info(row); const float* xr = wsp<float>(c, OFF_XL) + (size_t)row * D_MODEL;
    const float g = c.in[I_NORMG][(layer * 2 + which) * D_MODEL + col];
    return xr[col] * rstd * g * (1.0f + modp(c, layer, ri.mrow, which * 3 + 1)[col]) + modp(c, layer, ri.mrow, which * 3 + 0)[col];
}
HD void top2(const float (&lg)[NEXP], int& i0, int& i1, float& w0, float& w1) {
    float v0 = lg[0], v1 = -3.0e38f; int a0 = 0, a1 = 1;
#pragma unroll
    for (int e = 1; e < NEXP; ++e) { const float x = lg[e]; const bool g0 = x > v0, g1 = x > v1;
        const float nv1 = g0 ? v0 : (g1 ? x : v1); const int na1 = g0 ? a0 : (g1 ? e : a1);
        v0 = g0 ? x : v0; a0 = g0 ? e : a0; v1 = nv1; a1 = na1; }
    i0 = a0; i1 = a1; w0 = 1.0f / (1.0f + expf(v1 - v0)); w1 = 1.0f - w0;
}
HD float spec_dot(const bf16* a, const float* w, int ldw, int K, int col) { float s = 0.f; for (int k = 0; k < K; ++k) s += bf2f(a[k]) * bfr(w[(size_t)k * ldw + col]); return s; }
HD float spec_conv(const Ctx& c, int j, int row, int ch) {
    const RowInfo ri = row_info(row); const bf16* Y1 = wsp<bf16>(c, OFF_Y1);
    float s = c.in[I_LRU_CB][j * LRU_W + ch];
#pragma unroll
    for (int k = 0; k < 4; ++k) { const int tt = ri.t + k - 2; if (tt >= 0 && tt < ri.L) s += bf2f(Y1[(size_t)(ri.seq0 + tt) * (2 * LRU_W) + LRU_W + ch]) * c.in[I_LRU_CW][(j * 4 + k) * LRU_W + ch]; }
    return s;
}
HD float spec_gate(const Ctx& c, int j, int row, int q, int ch) {
    const bf16* U = wsp<bf16>(c, OFF_U) + (size_t)row * LRU_W; const int blk = ch / LRU_BS, kk = ch % LRU_BS;
    const float* w = c.in[I_LRU_WG] + ((size_t)(j * 4 + q) * LRU_NB + blk) * LRU_BS * LRU_BS;
    float s = 0.f; for (int jj = 0; jj < LRU_BS; ++jj) s += bf2f(U[blk * LRU_BS + jj]) * bfr(w[jj * LRU_BS + kk]);
    return s;
}
HD void lru_coef(const Ctx& c, int j, int row, int d, int ch, float& a, float& bx) {
    const bf16* GT = wsp<bf16>(c, OFF_GT) + (size_t)row * (4 * LRU_W);
    const float gr = bf2f(GT[(d * 2 + 0) * LRU_W + ch]) + c.in[I_LRU_BG][((j * 2 + d) * 2 + 0) * LRU_W + ch];
    const float gi = bf2f(GT[(d * 2 + 1) * LRU_W + ch]) + c.in[I_LRU_BG][((j * 2 + d) * 2 + 1) * LRU_W + ch];
    const float r = sigmoidf_(gr), i = sigmoidf_(gi), la = -wsp<float>(c, OFF_SP8)[(j * 2 + d) * LRU_W + ch] * r;
    a = expf(la); bx = sqrtf(-expm1f(2.0f * la)) * (i * bf2f(wsp<bf16>(c, OFF_U)[(size_t)row * LRU_W + ch]));
}
HD int chunk_row0(int b, int cidx) { return cidx < NCHK_C ? M_LAT + b * CTX + cidx * SCH : b * SEQ + (cidx - NCHK_C) * SCH; }
HD int chunk_at(int d, int s) { if (d == 0) return s; return s < NCHK_C ? NCHK_C - 1 - s : NCHK_C + (NCHK - 1 - s); }
DV void ph_scan1(const Ctx& c, int j, int gtid, int gn) {
    float* PSP = wsp<float>(c, OFF_PSP); float* PSS = wsp<float>(c, OFF_PSS);
    const bf16* GT = wsp<bf16>(c, OFF_GT); const bf16* U = wsp<bf16>(c, OFF_U); const float* SP8 = wsp<float>(c, OFF_SP8);
    constexpr int W2 = LRU_W / 2;
    for (int idx = gtid; idx < BATCH * 2 * NCHK * W2; idx += gn) {
        const int ch = 2 * (idx % W2), cidx = (idx / W2) % NCHK, d = (idx / (W2 * NCHK)) % 2, b = idx / (W2 * NCHK * 2);
        const int r0 = chunk_row0(b, cidx);
        const float* bg = c.in[I_LRU_BG] + ((j * 2 + d) * 2) * LRU_W + ch; const float br0 = bg[0], br1 = bg[1], bi0 = bg[LRU_W], bi1 = bg[LRU_W + 1];
        const float sp0 = SP8[(j * 2 + d) * LRU_W + ch], sp1 = SP8[(j * 2 + d) * LRU_W + ch + 1];
        bf16* HL = wsp<bf16>(c, OFF_HL) + (size_t)d * M_ALL * LRU_W + ch; bf16* PC = wsp<bf16>(c, OFF_PC) + (size_t)d * M_ALL * LRU_W + ch;
        float P0 = 1.f, P1 = 1.f, S0 = 0.f, S1 = 0.f;
#pragma unroll 8
        for (int s = 0; s < SCH; ++s) {
            const int row = r0 + (d == 0 ? s : SCH - 1 - s);
            const unsigned gr = *(const unsigned*)(GT + (size_t)row * (4 * LRU_W) + (d * 2 + 0) * LRU_W + ch), gi = *(const unsigned*)(GT + (size_t)row * (4 * LRU_W) + (d * 2 + 1) * LRU_W + ch);
            const unsigned uu = *(const unsigned*)(U + (size_t)row * LRU_W + ch);
            const float la0 = -sp0 * fsigmoid(bf2f((bf16)gr) + br0), la1 = -sp1 * fsigmoid(bf2f((bf16)(gr >> 16)) + br1);
            const float a0 = FEXP(la0), a1 = FEXP(la1);
            const float bx0 = sqrtf(neg_expm1_small(2.0f * la0)) * fsigmoid(bf2f((bf16)gi) + bi0) * bf2f((bf16)uu);
            const float bx1 = sqrtf(neg_expm1_small(2.0f * la1)) * fsigmoid(bf2f((bf16)(gi >> 16)) + bi1) * bf2f((bf16)(uu >> 16));
            P0 *= a0; P1 *= a1; S0 = a0 * S0 + bx0; S1 = a1 * S1 + bx1;
            *(unsigned*)(HL + (size_t)row * LRU_W) = (unsigned)f2bf(S0) | ((unsigned)f2bf(S1) << 16);
            *(unsigned*)(PC + (size_t)row * LRU_W) = (unsigned)f2bf(P0) | ((unsigned)f2bf(P1) << 16);
        }
        const size_t o = ((size_t)(b * 2 + d) * NCHK + cidx) * LRU_W + ch;
        PSP[o] = P0; PSP[o + 1] = P1; PSS[o] = S0; PSS[o + 1] = S1;
    }
}
DV void ph_scan2(const Ctx& c, int gtid, int gn) {
    const float* PSP = wsp<float>(c, OFF_PSP); const float* PSS = wsp<float>(c, OFF_PSS); float* CIN = wsp<float>(c, OFF_CIN);
    for (int idx = gtid; idx < BATCH * 2 * LRU_W; idx += gn) {
        const int ch = idx % LRU_W, d = (idx / LRU_W) % 2, b = idx / (LRU_W * 2); float st = 0.f;
        for (int s = 0; s < NCHK; ++s) { const int cidx = chunk_at(d, s); const size_t o = ((size_t)(b * 2 + d) * NCHK + cidx) * LRU_W + ch; CIN[o] = st; st = PSP[o] * st + PSS[o]; }
    }
}
DV void ph_scan3(const Ctx& c, int j, int nrows, int gtid, int gn) {
    typedef unsigned u4v __attribute__((ext_vector_type(4))); typedef float f4v __attribute__((ext_vector_type(4)));
    const float* CIN = wsp<float>(c, OFF_CIN); const bf16* Y1 = wsp<bf16>(c, OFF_Y1); bf16* A2 = wsp<bf16>(c, OFF_A2);
    const bf16* HL = wsp<bf16>(c, OFF_HL); const bf16* PC = wsp<bf16>(c, OFF_PC);
    constexpr int W8 = LRU_W / 8;
    for (size_t idx = gtid; idx < (size_t)nrows * W8; idx += gn) {
        const int row = (int)(idx / W8), ch = 8 * (int)(idx % W8);
        int b, cidx; if (row < M_LAT) { b = row / SEQ; cidx = NCHK_C + (row % SEQ) / SCH; } else { const int q = row - M_LAT; b = q / CTX; cidx = (q % CTX) / SCH; }
        const u4v y = *(const u4v*)(Y1 + (size_t)row * (2 * LRU_W) + ch);
        float h[8];
#pragma unroll
        for (int x = 0; x < 8; ++x) h[x] = 0.f;
#pragma unroll
        for (int d = 0; d < 2; ++d) {
            const u4v hl = *(const u4v*)(HL + ((size_t)d * M_ALL + row) * LRU_W + ch), pc = *(const u4v*)(PC + ((size_t)d * M_ALL + row) * LRU_W + ch);
            const float* ci = CIN + ((size_t)(b * 2 + d) * NCHK + cidx) * LRU_W + ch; const f4v c0 = *(const f4v*)ci, c1 = *(const f4v*)(ci + 4);
#pragma unroll
            for (int x = 0; x < 4; ++x) { const float cl = x < 2 ? c0[2 * x] : c1[2 * x - 4], chh = x < 2 ? c0[2 * x + 1] : c1[2 * x - 3];
                h[2 * x] += bf2f((bf16)hl[x]) + bf2f((bf16)pc[x]) * cl; h[2 * x + 1] += bf2f((bf16)(hl[x] >> 16)) + bf2f((bf16)(pc[x] >> 16)) * chh; }
        }
        u4v o;
#pragma unroll
        for (int x = 0; x < 4; ++x) o[x] = (unsigned)f2bf(fgelu(bf2f((bf16)y[x])) * h[2 * x]) | ((unsigned)f2bf(fgelu(bf2f((bf16)(y[x] >> 16))) * h[2 * x + 1]) << 16);
        *(u4v*)(A2 + (size_t)row * LRU_W + ch) = o;
    }
}
DV void ph_conv(const Ctx& c, int j, int gtid, int gn) {
    bf16* U = wsp<bf16>(c, OFF_U);
    for (size_t idx = gtid; idx < (size_t)M_ALL * LRU_W; idx += gn) U[idx] = f2bf(spec_conv(c, j, (int)(idx / LRU_W), (int)(idx % LRU_W)));
}

DV void ph_ret_rope(const Ctx& c, int gtid, int gn) {
    bf16* QKG = wsp<bf16>(c, OFF_QKG); bf16* KVT = wsp<bf16>(c, OFF_KVT);
    const float* RC = wsp<float>(c, OFF_RCOS); const float* RS = wsp<float>(c, OFF_RSIN);
    constexpr int NF = RET_DK / 2; const float ksc = 1.0f / sqrtf((float)RET_DK);
    for (size_t idx = gtid; idx < (size_t)M_ALL * RET_H * NF; idx += gn) {
        const int i = (int)(idx % NF), h = (int)((idx / NF) % RET_H), row = (int)(idx / ((size_t)NF * RET_H));
        float cs = 1.f, sn = 0.f; if (row < M_LAT) { const int t = row % SEQ; cs = RC[t * NF + i]; sn = RS[t * NF + i]; }
        bf16* q = QKG + (size_t)row * RET_NQKG + h * RET_DK; bf16* k = q + RET_DKT;
        const float q1 = bf2f(q[i]), q2 = bf2f(q[i + NF]); q[i] = f2bf(q1 * cs - q2 * sn); q[i + NF] = f2bf(q2 * cs + q1 * sn);
        const float k1 = bf2f(k[i]) * ksc, k2 = bf2f(k[i + NF]) * ksc; k[i] = f2bf(k1 * cs - k2 * sn); k[i + NF] = f2bf(k2 * cs + k1 * sn);
    }
    for (size_t idx = gtid; idx < (size_t)M_ALL * RET_H * NF; idx += gn) {
        const int row = (int)(idx % M_ALL), i = (int)((idx / M_ALL) % NF), h = (int)(idx / ((size_t)M_ALL * NF));
        float cs = 1.f, sn = 0.f; if (row < M_LAT) { const int t = row % SEQ; cs = RC[t * NF + i]; sn = RS[t * NF + i]; }
        bf16* kt1 = KVT + (size_t)(h * RET_DK + i) * M_ALL + row; bf16* kt2 = KVT + (size_t)(h * RET_DK + i + NF) * M_ALL + row;
        const float t1 = bf2f(*kt1) * ksc, t2 = bf2f(*kt2) * ksc; *kt1 = f2bf(t1 * cs - t2 * sn); *kt2 = f2bf(t2 * cs + t1 * sn);
    }
}
HD int ret_row_at(int b, int d, int p) { if (p < CTX) return M_LAT + b * CTX + (d == 0 ? p : CTX - 1 - p); const int q = p - CTX; return b * SEQ + (d == 0 ? q : SEQ - 1 - q); }
HD int ret_pos_of(int row, int d, int& b) { if (row < M_LAT) { b = row / SEQ; const int t = row % SEQ; return CTX + (d == 0 ? t : SEQ - 1 - t); } const int q = row - M_LAT; b = q / CTX; const int s = q % CTX; return d == 0 ? s : CTX - 1 - s; }
HD float spec_ret(const Ctx& c, int row, int h, int e, int d) {
    const bf16* QKG = wsp<bf16>(c, OFF_QKG); const bf16* KVT = wsp<bf16>(c, OFF_KVT);
    const float lg = c.in[I_RET_LD][d * RET_H + h]; int b; const int p = ret_pos_of(row, d, b);
    const bf16* q = QKG + (size_t)row * RET_NQKG + h * RET_DK; const bf16* vt = KVT + (size_t)(RET_DKT + h * RET_DV + e) * M_ALL;
    float o = 0.f;
    for (int s = 0; s <= p; ++s) { const int rs = ret_row_at(b, d, s); const bf16* k = QKG + (size_t)rs * RET_NQKG + RET_DKT + h * RET_DK;
        float dot = 0.f; for (int x = 0; x < RET_DK; ++x) dot += bf2f(q[x]) * bf2f(k[x]);
        o += expf(lg * (float)(p - s)) * dot * bf2f(vt[rs]); }
    return o;
}
HD float spec_ret_comb(const Ctx& c, int row, int h, int e) {
    const bf16* OF = wsp<bf16>(c, OFF_OF) + (size_t)row * RET_DVT + h * RET_DV; const bf16* OB = wsp<bf16>(c, OFF_OB) + (size_t)row * RET_DVT + h * RET_DV;
    float ss = 0.f; for (int x = 0; x < RET_DV; ++x) { const float o = bf2f(OF[x]) + bf2f(OB[x]); ss += o * o; }
    const float o = bf2f(OF[e]) + bf2f(OB[e]), g = bf2f(wsp<bf16>(c, OFF_QKG)[(size_t)row * RET_NQKG + 2 * RET_DKT + h * RET_DV + e]);
    return siluf_(g) * (o / sqrtf(ss / RET_DV + EPS)) * c.in[I_RET_GN][h * RET_DV + e];
}

DV void ph_swa_rope(const Ctx& c, int gtid, int gn) {
    bf16* QKV = wsp<bf16>(c, OFF_QKV); const float* SC = wsp<float>(c, OFF_SCOS); const float* SS = wsp<float>(c, OFF_SSIN);
    constexpr int HF = SWA_DH / 2, NH = SWA_HQ + SWA_HKV;
    for (size_t idx = gtid; idx < (size_t)M_LAT * NH * HF; idx += gn) {
        const int i = (int)(idx % HF), hh = (int)((idx / HF) % NH), row = (int)(idx / ((size_t)HF * NH)); const int t = row % SEQ;
        bf16* p = QKV + (size_t)row * SWA_N + hh * SWA_DH; const float cs = SC[t * HF + i], sn = SS[t * HF + i];
        const float x1 = bf2f(p[i]), x2 = bf2f(p[i + HF]); p[i] = f2bf(x1 * cs - x2 * sn); p[i + HF] = f2bf(x2 * cs + x1 * sn);
    }
}
HD float swa_score(const bf16* q, const bf16* k) { float s = 0.f; for (int x = 0; x < SWA_DH; ++x) s += bf2f(q[x]) * bf2f(k[x]); return s * (1.0f / sqrtf((float)SWA_DH)); }
HD float spec_swa(const Ctx& c, int row, int hq, int dd) {
    const bf16* QKV = wsp<bf16>(c, OFF_QKV); const int hk = hq / SWA_G; const float sink = c.in[I_SWA_SINK][hq];
    const bf16* q = QKV + (size_t)row * SWA_N + hq * SWA_DH; const RowInfo ri = row_info(row);
    const int b = row < M_LAT ? row / SEQ : (row - M_LAT) / CTX;
    int k0 = 0, k1 = -1; if (row < M_LAT) { const int n = ri.t / SWA_BLK; k0 = (n - 1) * SWA_BLK; k1 = (n + 2) * SWA_BLK - 1; }
    float mx = sink;
    for (int kp = k0; kp <= k1; ++kp) { if (kp < 0 || kp >= SEQ || kp - ri.t > SWA_WIN || ri.t - kp > SWA_WIN) continue; const float s = swa_score(q, QKV + (size_t)(b * SEQ + kp) * SWA_N + SWA_NQ + hk * SWA_DH); mx = s > mx ? s : mx; }
    for (int kc = 0; kc < CTX; ++kc) { const float s = swa_score(q, QKV + (size_t)(M_LAT + b * CTX + kc) * SWA_N + SWA_NQ + hk * SWA_DH); mx = s > mx ? s : mx; }
    float l = expf(sink - mx), o = 0.f;
    for (int kp = k0; kp <= k1; ++kp) { if (kp < 0 || kp >= SEQ || kp - ri.t > SWA_WIN || ri.t - kp > SWA_WIN) continue; const bf16* kr = QKV + (size_t)(b * SEQ + kp) * SWA_N + SWA_NQ + hk * SWA_DH;
        const float pz = expf(swa_score(q, kr) - mx); l += pz; o += pz * bf2f(kr[SWA_NKV + dd]); }
    for (int kc = 0; kc < CTX; ++kc) { const bf16* kr = QKV + (size_t)(M_LAT + b * CTX + kc) * SWA_N + SWA_NQ + hk * SWA_DH;
        const float pz = expf(swa_score(q, kr) - mx); l += pz; o += pz * bf2f(kr[SWA_NKV + dd]); }
    return o / l;
}

DV void ph_moe_combine(const Ctx& c, int layer  , int nrows, int gtid, int gn) {
    float* XL = wsp<float>(c, OFF_XL); const bf16* YP = wsp<bf16>(c, OFF_YP); const int* SLOT = wsp<int>(c, OFF_SLOT); const float* TOPW = wsp<float>(c, OFF_TOPW);
    for (size_t idx = gtid; idx < (size_t)nrows * D_MODEL; idx += gn) {
        const int row = (int)(idx / D_MODEL), col = (int)(idx % D_MODEL); const RowInfo ri = row_info(row);
        const float y = TOPW[row * 2] * bf2f(YP[(size_t)SLOT[row * 2] * D_MODEL + col]) + TOPW[row * 2 + 1] * bf2f(YP[(size_t)SLOT[row * 2 + 1] * D_MODEL + col]);
        XL[idx] += modp(c, layer, ri.mrow, 5)[col] * y;
    }
}
HD unsigned atomic_add_u32(unsigned* p, unsigned v) {
#ifdef CPU_SHIM
    const unsigned o = *p; *p = o + v; return o;
#else
    return atomicAdd(p, v);
#endif
}
HD int moe_off(const unsigned* cnt, int e) { int o = 0;
#pragma unroll
    for (int x = 0; x < NEXP; ++x) if (x < e) o += ((int)cnt[x] + 255) / 256 * 256;
    return o; }
DV void ph_moe_perm(const Ctx& c, int f, int nrows, int gtid, int gn) {
    unsigned* ctl = wsp<unsigned>(c, OFF_CTL); const unsigned* cnt = ctl + CW_CNT + 64 * f; unsigned* cur = ctl + CW_CUR + 64 * f;
    const int* TOPI = wsp<int>(c, OFF_TOPI); int* SLOT = wsp<int>(c, OFF_SLOT); int* TILEE = wsp<int>(c, OFF_TILEE);
    for (int i = gtid; i < nrows * 2; i += gn) { const int e = TOPI[i]; SLOT[i] = moe_off(cnt, e) + (int)atomic_add_u32(cur + e, 1u); }
    const int ntile = moe_off(cnt, NEXP) / 256;
    for (int t = gtid; t < ntile; t += gn) { int e = 0, run = 0;
#pragma unroll
        for (int x = 0; x < NEXP - 1; ++x) { run += ((int)cnt[x] + 255) / 256 * 256; if (t * 256 >= run) e = x + 1; }
        TILEE[t] = e; }
}
DV void ph_moe_gather(const Ctx& c, int f, int nrows, int gtid, int gn) {
    const unsigned* cnt = wsp<unsigned>(c, OFF_CTL) + CW_CNT + 64 * f;
    const int* SLOT = wsp<int>(c, OFF_SLOT); const bf16* H = wsp<bf16>(c, OFF_H); bf16* AG = wsp<bf16>(c, OFF_AG);
    typedef unsigned u4 __attribute__((ext_vector_type(4))); constexpr int V = D_MODEL / 8;
    for (size_t idx = gtid; idx < (size_t)nrows * 2 * V; idx += gn) { const int i = (int)(idx / V), v = (int)(idx % V); ((u4*)(AG + (size_t)SLOT[i] * D_MODEL))[v] = ((const u4*)(H + (size_t)(i / 2) * D_MODEL))[v]; }
    for (size_t idx = gtid; idx < (size_t)NEXP * 256 * V; idx += gn) { const int e = (int)(idx / (256 * V)), r = (int)((idx / V) % 256), v = (int)(idx % V); const int s = moe_off(cnt, e) + (int)cnt[e] + r;
        if (s < moe_off(cnt, e + 1)) ((u4*)(AG + (size_t)s * D_MODEL))[v] = (u4){0u, 0u, 0u, 0u}; }
}

#ifndef CPU_SHIM
#define LAS __attribute__((address_space(3)))
typedef short bf16x8 __attribute__((ext_vector_type(8)));
typedef float f32x4 __attribute__((ext_vector_type(4)));
typedef float f32x2 __attribute__((ext_vector_type(2)));
typedef unsigned u32x4 __attribute__((ext_vector_type(4)));
typedef unsigned u32x2 __attribute__((ext_vector_type(2)));
constexpr int NTHREADS = 512, NWAVES = 8;
DV unsigned cvt_pk_bf16(float lo, float hi) { unsigned r; asm volatile("v_cvt_pk_bf16_f32 %0, %1, %2" : "=v"(r) : "v"(lo), "v"(hi)); return r; }
DV float wave_sum(float v) {
#pragma unroll
    for (int o = 1; o < 64; o <<= 1) v += __shfl_xor(v, o);
    return v;
}

namespace pg8 {
constexpr int BM = 256, BK = 64, HALF = 128, HTB = HALF * BK * 2, STAGE_BYTES = 8 * HTB, NXCD = 8, WGM = 8;
HD int lds_byte(int r, int c) { const int st = (r >> 4) * 2 + (c >> 5), rr = r & 15, cc = c & 31, ob = rr * 64 + cc * 2; return st * 1024 + (ob ^ (((ob >> 9) & 1) << 5)); }
HD void stage_rc(int b, int& R, int& C) { const int st = b / 1024, sb = b % 1024, swz = sb ^ (((sb >> 9) & 1) << 5); R = (st >> 1) * 16 + swz / 64; C = (st & 1) * 32 + (swz % 64) / 2; }
HD int perm32(int rho) { const int n = rho >> 4, i = rho & 15; return 8 * (i >> 2) + 4 * n + (i & 3); }
struct Unit { int pm, pn; const char* A; const char* B; };
struct Sched {
    int nM, nN, nwg, G, c;
    const char* A; size_t a_tile;
    int a_cmod; size_t a_cstep;
    const char* B; size_t b_tile;
    const int* tile_e; size_t b_exp;
    DV void init(int nM_, int nN_, int G_, int c_, const void* A_, size_t a_tile_, const void* B_, size_t b_tile_) {
        nM = nM_; nN = nN_; nwg = nM * nN; G = G_; c = c_; A = (const char*)A_; a_tile = a_tile_; a_cmod = 0; a_cstep = 0; B = (const char*)B_; b_tile = b_tile_; tile_e = nullptr; b_exp = 0; }
    DV bool next(int i, Unit& u) const {
        const long L = (long)i * G + c; if (L >= nwg) return false;
        int wgid = (int)L; { const int q = nwg / NXCD, r = nwg % NXCD, xcd = wgid % NXCD, off = wgid / NXCD; wgid = (xcd < r ? xcd * (q + 1) : r * (q + 1) + (xcd - r) * q) + off; }
        const int nig = WGM * nN, gid = wgid / nig, fm = gid * WGM, gsz = (nM - fm) < WGM ? (nM - fm) : WGM;
        u.pm = fm + ((wgid % nig) % gsz); u.pn = (wgid % nig) / gsz;
        u.A = A + (size_t)u.pm * a_tile + (a_cmod ? (size_t)(u.pn % a_cmod) * a_cstep : 0);
        u.B = B + (size_t)u.pn * b_tile + (tile_e ? (size_t)tile_e[u.pm] * b_exp : 0);
        return true;
    }
};
struct EpiBf16 {
    static constexpr bool PERM = true;
    bf16* O; size_t ldc;
    DV void operator()(const f32x4 (&acc)[2][2][4][2], const Unit& u, int wr, int wc, int fr, int fq) const {
        const int row0 = u.pm * BM + wr * 64 + fr, col0 = u.pn * BM + wc * 32 + 8 * fq;
#pragma unroll
        for (int ai = 0; ai < 2; ++ai)
#pragma unroll
            for (int m = 0; m < 4; ++m) { bf16* rowp = O + (size_t)(row0 + ai * HALF + m * 16) * ldc + col0;
#pragma unroll
                for (int bj = 0; bj < 2; ++bj) { const f32x4 v0 = acc[ai][bj][m][0], v1 = acc[ai][bj][m][1];
                    u32x4 w; w.x = cvt_pk_bf16(v0[0], v0[1]); w.y = cvt_pk_bf16(v0[2], v0[3]); w.z = cvt_pk_bf16(v1[0], v1[1]); w.w = cvt_pk_bf16(v1[2], v1[3]);
                    *(u32x4*)(rowp + bj * HALF) = w; } }
    }
};
struct EpiSwiglu {
    static constexpr bool PERM = true;
    bf16* O; size_t ldc;
    DV void operator()(const f32x4 (&acc)[2][2][4][2], const Unit& u, int wr, int wc, int fr, int fq) const {
        const int row0 = u.pm * BM + wr * 64 + fr, col0 = u.pn * HALF + wc * 32 + 8 * fq;
#pragma unroll
        for (int ai = 0; ai < 2; ++ai)
#pragma unroll
            for (int m = 0; m < 4; ++m) { bf16* rowp = O + (size_t)(row0 + ai * HALF + m * 16) * ldc + col0;
                float h[8];
#pragma unroll
                for (int n = 0; n < 2; ++n)
#pragma unroll
                    for (int x = 0; x < 4; ++x) { const float g = acc[ai][0][m][n][x], uu = acc[ai][1][m][n][x]; h[n * 4 + x] = g * __builtin_amdgcn_rcpf(1.0f + __expf(-g)) * uu; }
                u32x4 w; w.x = cvt_pk_bf16(h[0], h[1]); w.y = cvt_pk_bf16(h[2], h[3]); w.z = cvt_pk_bf16(h[4], h[5]); w.w = cvt_pk_bf16(h[6], h[7]);
                *(u32x4*)rowp = w; }
    }
};
struct EpiResid {
    static constexpr bool PERM = false;
    float* X; size_t ldc; const float* gate; size_t gstride;
    DV void operator()(const f32x4 (&acc)[2][2][4][2], const Unit& u, int wr, int wc, int fr, int fq) const {
        const int row0 = u.pm * BM + wr * 64 + fr, col0 = u.pn * BM + wc * 32 + 4 * fq;
        const int r0 = u.pm * BM; const int mrow = r0 < M_LAT ? r0 / SEQ : BATCH;
        const float* gp = gate + (size_t)mrow * gstride + col0;
        f32x4 gv[2][2];
#pragma unroll
        for (int bj = 0; bj < 2; ++bj)
#pragma unroll
            for (int n = 0; n < 2; ++n) gv[bj][n] = *(const f32x4*)(gp + bj * HALF + n * 16);
#pragma unroll
        for (int ai = 0; ai < 2; ++ai)
#pragma unroll
            for (int m = 0; m < 4; ++m) { float* rowp = X + (size_t)(row0 + ai * HALF + m * 16) * ldc + col0;
#pragma unroll
                for (int bj = 0; bj < 2; ++bj)
#pragma unroll
                    for (int n = 0; n < 2; ++n) { f32x4* p = (f32x4*)(rowp + bj * HALF + n * 16); *p = *p + gv[bj][n] * acc[ai][bj][m][n]; } }
    }
};

template <class Epi>
DV void gemm_phase(LAS unsigned char* lds, const int K, const int lda, const int ldb, const Sched& S, const Epi& E) {
    int tid = threadIdx.x; asm volatile("" : "+v"(tid));
    const int wid = __builtin_amdgcn_readfirstlane(tid >> 6), lane = tid & 63, wr = wid >> 2, wc = wid & 3, fr = lane & 15, fq = lane >> 4;
    const int nt = K / BK;
    unsigned voffA[2], voffB[2];
#pragma unroll
    for (int i = 0; i < 2; ++i) { int R, C; stage_rc(tid * 16 + i * 8192, R, C); const int Rb = Epi::PERM ? ((R & ~31) + perm32(R & 31)) : R;
        voffA[i] = (unsigned)(R * lda + C) * 2u; voffB[i] = (unsigned)(Rb * ldb + C) * 2u; }
    const size_t kstep = (size_t)(BK * 2);
    const size_t hstepA = (size_t)HALF * lda * 2, hstepB = (size_t)HALF * ldb * 2;
    const unsigned ldsw = (unsigned)wid * 1024u;
    const int aoff = lds_byte(wr * 64 + fr, fq * 8), boff = lds_byte(wc * 32 + fr, fq * 8);
#define PG8_SA(b, h) (((b) * 2 + (h)) * HTB)
#define PG8_SB(b, h) ((4 + (b) * 2 + (h)) * HTB)
#define PG8_STAGE(bufoff, gbase, voff) do { _Pragma("unroll") for (int _i = 0; _i < 2; ++_i) \
        __builtin_amdgcn_global_load_lds((const unsigned*)((const char*)(gbase) + (voff)[_i]), (LAS unsigned*)(lds + (bufoff) + ldsw + _i * 8192), 16, 0, 0); } while (0)
#define PG8_LDA(dst, b, h) do { _Pragma("unroll") for (int m = 0; m < 4; ++m) _Pragma("unroll") for (int k = 0; k < 2; ++k) dst[m][k] = *(const LAS bf16x8*)(lds + PG8_SA(b, h) + aoff + m * 2048 + k * 1024); } while (0)
#define PG8_LDB(dst, b, h) do { _Pragma("unroll") for (int n = 0; n < 2; ++n) _Pragma("unroll") for (int k = 0; k < 2; ++k) dst[n][k] = *(const LAS bf16x8*)(lds + PG8_SB(b, h) + boff + n * 2048 + k * 1024); } while (0)
#define PG8_MMA(ai, bj, At, Bt) do { __builtin_amdgcn_s_setprio(1); _Pragma("unroll") for (int m = 0; m < 4; ++m) _Pragma("unroll") for (int n = 0; n < 2; ++n) _Pragma("unroll") for (int k = 0; k < 2; ++k) \
        acc[ai][bj][m][n] = __builtin_amdgcn_mfma_f32_16x16x32_bf16(Bt[n][k], At[m][k], acc[ai][bj][m][n], 0, 0, 0); __builtin_amdgcn_s_setprio(0); } while (0)
#define PG8_WAIT_V(n) asm volatile("s_waitcnt vmcnt(" #n ")" ::: "memory")
#define PG8_WAIT_L(n) asm volatile("s_waitcnt lgkmcnt(" #n ")" ::: "memory")
#define PG8_BAR __builtin_amdgcn_s_barrier()
#define PG8_SCHED __builtin_amdgcn_sched_barrier(0)
    Unit cur, nxt; int ui = 0;
    if (!S.next(0, cur)) return;
    f32x4 acc[2][2][4][2];
#pragma unroll
    for (int a = 0; a < 2; ++a)
#pragma unroll
        for (int b = 0; b < 2; ++b)
#pragma unroll
            for (int m = 0; m < 4; ++m)
#pragma unroll
                for (int n = 0; n < 2; ++n) acc[a][b][m][n] = (f32x4){0.f, 0.f, 0.f, 0.f};
    bf16x8 At[4][2], B0[2][2], B1[2][2];
    const char* cA = cur.A; const char* cB = cur.B;
    PG8_STAGE(PG8_SB(0, 0), cB, voffB); PG8_STAGE(PG8_SB(0, 1), cB + hstepB, voffB); PG8_STAGE(PG8_SA(0, 0), cA, voffA); PG8_STAGE(PG8_SA(0, 1), cA + hstepA, voffA);
    if (wr == 1) PG8_BAR;
    PG8_WAIT_V(2); PG8_BAR;
    PG8_STAGE(PG8_SB(1, 0), cB + kstep, voffB); PG8_STAGE(PG8_SA(1, 0), cA + kstep, voffA); PG8_STAGE(PG8_SB(1, 1), cB + hstepB + kstep, voffB);
    PG8_WAIT_V(6); PG8_BAR;
    for (;;) {
        const bool has_next = S.next(ui + 1, nxt);
        const char* nA = has_next ? nxt.A : cA; const char* nB = has_next ? nxt.B : cB;
        for (int t = 0; t < nt; t += 2) {
            const bool last = (t == nt - 2);
            const char* a1 = cA + (size_t)(t + 1) * kstep;
            const char* a2 = last ? nA : cA + (size_t)(t + 2) * kstep; const char* b2 = last ? nB : cB + (size_t)(t + 2) * kstep;
            const char* a3 = a2 + kstep; const char* b3 = b2 + kstep;
            PG8_LDB(B0, 0, 0); PG8_LDB(B1, 0, 1); PG8_SCHED; PG8_LDA(At, 0, 0); PG8_STAGE(PG8_SA(1, 1), a1 + hstepA, voffA);
            PG8_WAIT_V(8); PG8_WAIT_L(0); PG8_BAR; PG8_MMA(0, 0, At, B0); PG8_MMA(0, 1, At, B1); PG8_BAR; PG8_SCHED;
            PG8_LDA(At, 0, 1); PG8_STAGE(PG8_SB(0, 0), b2, voffB); PG8_STAGE(PG8_SB(0, 1), b2 + hstepB, voffB); PG8_STAGE(PG8_SA(0, 0), a2, voffA);
            PG8_WAIT_V(8); PG8_WAIT_L(0); PG8_BAR; PG8_MMA(1, 0, At, B0); PG8_MMA(1, 1, At, B1); PG8_BAR; PG8_SCHED;
            PG8_LDB(B0, 1, 0); PG8_LDB(B1, 1, 1); PG8_SCHED; PG8_LDA(At, 1, 0); PG8_STAGE(PG8_SA(0, 1), a2 + hstepA, voffA);
            PG8_WAIT_V(8); PG8_WAIT_L(0); PG8_BAR; PG8_MMA(0, 0, At, B0); PG8_MMA(0, 1, At, B1); PG8_BAR; PG8_SCHED;
            PG8_LDA(At, 1, 1); PG8_STAGE(PG8_SB(1, 0), b3, voffB); PG8_STAGE(PG8_SB(1, 1), b3 + hstepB, voffB); PG8_STAGE(PG8_SA(1, 0), a3, voffA);
            PG8_WAIT_V(8); PG8_WAIT_L(0); PG8_BAR; PG8_MMA(1, 0, At, B0); PG8_MMA(1, 1, At, B1); PG8_BAR; PG8_SCHED;
        }
        if (wr == 0) PG8_BAR;
        E(acc, cur, wr, wc, fr, fq);
        if (!has_next) break;
#pragma unroll
        for (int a = 0; a < 2; ++a)
#pragma unroll
            for (int b = 0; b < 2; ++b)
#pragma unroll
                for (int m = 0; m < 4; ++m)
#pragma unroll
                    for (int n = 0; n < 2; ++n) acc[a][b][m][n] = (f32x4){0.f, 0.f, 0.f, 0.f};
        cur = nxt; cA = nA; cB = nB; ++ui;
        if (wr == 1) PG8_BAR;
    }
    PG8_WAIT_V(0);
    PG8_BAR;
#undef PG8_SA
#undef PG8_SB
#undef PG8_STAGE
#undef PG8_LDA
#undef PG8_LDB
#undef PG8_MMA
#undef PG8_WAIT_V
#undef PG8_WAIT_L
#undef PG8_BAR
#undef PG8_SCHED
}
}

#define XB_TMO      128
#define XB_XCNT(j)  (256  + 64 * (j))
#define XB_XSUB(j)  (1280 + 64 * (j))
#define XB_XGEN(j)  (2304 + 64 * (j))
#define XB_TOP      3328
#define XB_TOPGEN   3392
#define XCD_BAR_WORDS 3456
#define XB_SPIN_CAP (1u << 24)
__device__ __forceinline__ unsigned xb_ld(unsigned* p)              { return __hip_atomic_load(p, __ATOMIC_RELAXED, __HIP_MEMORY_SCOPE_AGENT); }
__device__ __forceinline__ unsigned xb_add(unsigned* p, unsigned v) { return __hip_atomic_fetch_add(p, v, __ATOMIC_RELAXED, __HIP_MEMORY_SCOPE_AGENT); }
__device__ __forceinline__ unsigned xb_xcc_id() { return (unsigned)__builtin_amdgcn_s_getreg((3 << 11) | 20) & 0xFu; }
#define XB_SPIN(cond, bar) do { unsigned _sp = 0; while (cond) { __builtin_amdgcn_s_sleep(1); \
    if ((++_sp & 255u) == 0u) { if (xb_ld(&(bar)[XB_TMO])) break; if (_sp > XB_SPIN_CAP) { atomicAdd(&(bar)[XB_TMO], 1u); break; } } } } while (0)
struct XcdBarrier { unsigned* bar; unsigned x; volatile LAS unsigned* st; };
__device__ __forceinline__ XcdBarrier xcd_barrier_post(unsigned* bar, volatile LAS unsigned* st) {
    XcdBarrier b; b.bar = bar; b.x = xb_xcc_id(); b.st = st;
    if (threadIdx.x == 0) (void)xb_add(&bar[XB_XCNT(b.x)], 1u);
    return b;
}
__device__ __forceinline__ void xcd_barrier_complete(unsigned* bar, unsigned x, unsigned& nloc, unsigned& nx) {
    const unsigned G = gridDim.x * gridDim.y * gridDim.z;
    unsigned sum, cnt, mine, sp = 0u;
    for (;;) {
        sum = 0u; cnt = 0u; mine = 0u;
#pragma unroll
        for (unsigned j = 0; j < 16; ++j) { const unsigned c = xb_ld(&bar[XB_XCNT(j)]); sum += c; cnt += (c > 0u) ? 1u : 0u; mine = (j == x) ? c : mine; }
        if (sum == G) break;
        __builtin_amdgcn_s_sleep(1);
        if ((++sp & 255u) == 0u) { if (xb_ld(&bar[XB_TMO])) break; if (sp > XB_SPIN_CAP) { atomicAdd(&bar[XB_TMO], 1u); break; } }
    }
    nloc = mine > 0u ? mine : 1u; nx = cnt > 0u ? cnt : 1u;
}
__device__ __forceinline__ void xcd_barrier(const XcdBarrier& b) {
    asm volatile("s_waitcnt vmcnt(0)" ::: "memory");
    __syncthreads();
    if (threadIdx.x == 0) {
        unsigned* bar = b.bar;
        __builtin_amdgcn_s_waitcnt(0);
        unsigned nloc = b.st[0], nx = b.st[1];
        if (nloc == 0u) { xcd_barrier_complete(bar, b.x, nloc, nx); b.st[0] = nloc; b.st[1] = nx; }
        const unsigned old = xb_add(&bar[XB_XSUB(b.x)], 1u);
        const unsigned gen = old / nloc;
        if (old + 1u == (gen + 1u) * nloc) {
            __builtin_amdgcn_fence(__ATOMIC_RELEASE, "agent");
            asm volatile("s_waitcnt vmcnt(0)" ::: "memory");
            const unsigned og = xb_add(&bar[XB_TOP], 1u);
            const unsigned tg = og / nx;
            if (og + 1u == (tg + 1u) * nx) xb_add(&bar[XB_TOPGEN], 1u);
            else XB_SPIN(xb_ld(&bar[XB_TOPGEN]) == tg, bar);
            __builtin_amdgcn_fence(__ATOMIC_ACQUIRE, "agent");
            xb_add(&bar[XB_XGEN(b.x)], 1u);
            asm volatile("s_waitcnt vmcnt(0)" ::: "memory");
        } else {
            XB_SPIN(xb_ld(&bar[XB_XGEN(b.x)]) == gen, bar);
            __builtin_amdgcn_fence(__ATOMIC_ACQUIRE, "agent");
            asm volatile("s_waitcnt vmcnt(0)" ::: "memory");
        }
    }
    __syncthreads();
}

DV void conv_item(const float* W, int ldw, int srccol0, bf16* WT, int K, int destrow0, int k0, LAS float* scr, int lane) {
#pragma unroll 8
    for (int i = 0; i < 32; ++i) { const int kk = 2 * i + (lane >> 5); scr[kk * 33 + (lane & 31)] = W[(size_t)(k0 + kk) * ldw + srccol0 + (lane & 31)]; }
    asm volatile("s_waitcnt lgkmcnt(0)" ::: "memory");
    const int cch = lane & 7;
#pragma unroll
    for (int j = 0; j < 4; ++j) { const int n = (lane >> 3) + 8 * j; const LAS float* s = scr + (8 * cch) * 33 + n;
        u32x4 o; o.x = cvt_pk_bf16(s[0 * 33], s[1 * 33]); o.y = cvt_pk_bf16(s[2 * 33], s[3 * 33]); o.z = cvt_pk_bf16(s[4 * 33], s[5 * 33]); o.w = cvt_pk_bf16(s[6 * 33], s[7 * 33]);
        *(u32x4*)(WT + (size_t)(destrow0 + n) * K + k0 + 8 * cch) = o; }
    asm volatile("s_waitcnt lgkmcnt(0)" ::: "memory");
}
DV int conv_srccol(int mapkind, int coloff, int n0) {
    if (mapkind == 1) return n0 < 2 * RET_DKT ? n0 : n0 + RET_DVT;
    if (mapkind == 2) { const int pn = n0 / 256, s = (n0 % 256) / 128, c0 = n0 % 128; return s * D_FF + 128 * pn + c0; }
    return n0 + coloff;
}
DV void conv_job(const float* W, int ldw, int K, int N, bf16* WT, int mapkind, int coloff, long& base, LAS float* scr, int gw, int ngw, int lane) {
    const int nblk = N / 32, nitems = (K / 64) * nblk;
    int it = (int)(((long)gw - base) % ngw); if (it < 0) it += ngw;
    for (; it < nitems; it += ngw) { const int kb = it / nblk, nb = it % nblk; conv_item(W, ldw, conv_srccol(mapkind, coloff, nb * 32), WT, K, nb * 32, kb * 64, scr, lane); }
    base += nitems;
}
DV void ph_convert(const Ctx& c, LAS unsigned char* lds, int gw, int ngw, int lane, int wave, int gtid, int gn) {
    LAS float* scr = (LAS float*)(lds + wave * 8704);
    long base = 0;
    for (int j = 0; j < 2; ++j) {
        conv_job(c.in[I_LRU_WIN] + (size_t)j * D_MODEL * 2 * LRU_W, 2 * LRU_W, D_MODEL, 2 * LRU_W, (bf16*)(c.ws + OFF_W_LRU_IN + j * SZ_W_LRU_IN), 0, 0, base, scr, gw, ngw, lane);
        conv_job(c.in[I_LRU_WOUT] + (size_t)j * LRU_W * D_MODEL, D_MODEL, LRU_W, D_MODEL, (bf16*)(c.ws + OFF_W_LRU_OUT + j * SZ_W_LRU_OUT), 0, 0, base, scr, gw, ngw, lane);
        conv_job(c.in[I_FFN_GU] + (size_t)j * D_MODEL * 2 * D_FF, 2 * D_FF, D_MODEL, 2 * D_FF, (bf16*)(c.ws + OFF_W_FFN_GU + j * SZ_W_GU), 2, 0, base, scr, gw, ngw, lane);
        conv_job(c.in[I_FFN_DN] + (size_t)j * D_FF * D_MODEL, D_MODEL, D_FF, D_MODEL, (bf16*)(c.ws + OFF_W_FFN_DN + j * SZ_W_DN), 0, 0, base, scr, gw, ngw, lane);
    }
    conv_job(c.in[I_RET_WIN], 2 * RET_DKT + 2 * RET_DVT, D_MODEL, RET_NQKG, (bf16*)(c.ws + OFF_W_RET_A), 1, 0, base, scr, gw, ngw, lane);
    conv_job(c.in[I_RET_WIN], 2 * RET_DKT + 2 * RET_DVT, D_MODEL, RET_NKV, (bf16*)(c.ws + OFF_W_RET_B), 0, RET_DKT, base, scr, gw, ngw, lane);
    conv_job(c.in[I_RET_WOUT], D_MODEL, RET_DVT, D_MODEL, (bf16*)(c.ws + OFF_W_RET_OUT), 0, 0, base, scr, gw, ngw, lane);
    conv_job(c.in[I_SWA_WIN], SWA_N, D_MODEL, SWA_N, (bf16*)(c.ws + OFF_W_SWA_IN), 0, 0, base, scr, gw, ngw, lane);
    conv_job(c.in[I_SWA_WOUT], D_MODEL, SWA_NQ, D_MODEL, (bf16*)(c.ws + OFF_W_SWA_OUT), 0, 0, base, scr, gw, ngw, lane);
    for (int fe = 0; fe < 2 * NEXP; ++fe) {
        conv_job(c.in[I_MOE_GU] + (size_t)fe * D_MODEL * 2 * D_FF, 2 * D_FF, D_MODEL, 2 * D_FF, (bf16*)(c.ws + OFF_W_MOE_GU + fe * SZ_W_GU), 2, 0, base, scr, gw, ngw, lane);
        conv_job(c.in[I_MOE_DN] + (size_t)fe * D_FF * D_MODEL, D_MODEL, D_FF, D_MODEL, (bf16*)(c.ws + OFF_W_MOE_DN + fe * SZ_W_DN), 0, 0, base, scr, gw, ngw, lane);
    }
    for (size_t idx = gtid; idx < (size_t)2 * 4 * LRU_W * 256; idx += gn) {
        const int cc = (int)(idx % 256), n = (int)((idx / 256) % (4 * LRU_W)), j = (int)(idx / ((size_t)256 * 4 * LRU_W));
        const int pn = n / 256, r = n % 256, q = pn / 5, p = pn % 5, blk = r / 128, k = r % 128, blk2 = cc / 128, jj = cc % 128;
        const float v = blk == blk2 ? c.in[I_LRU_WG][(((size_t)(j * 4 + q) * LRU_NB + 2 * p + blk) * LRU_BS + jj) * LRU_BS + k] : 0.f;
        ((bf16*)(c.ws + OFF_W_LRU_G + j * SZ_W_LRU_G))[(size_t)n * 256 + cc] = f2bf(v);
    }
}

template <int MODE, bool COMB>
DV void ph_norm_gpu(const Ctx& c, int layer, int which, int nrows, int comb_layer, int gw, int ngw, int lane) {
    float* XL = wsp<float>(c, OFF_XL); bf16* H = wsp<bf16>(c, OFF_H);
    for (int row = gw; row < nrows; row += ngw) {
        const int mrow = row < M_LAT ? row / SEQ : BATCH;
        f32x4* xr = (f32x4*)(XL + (size_t)row * D_MODEL) + lane; f32x4 v[4]; float ss = 0.f;
#pragma unroll
        for (int j = 0; j < 4; ++j) v[j] = xr[64 * j];
        if (COMB) {
            const int s0 = wsp<int>(c, OFF_SLOT)[row * 2], s1 = wsp<int>(c, OFF_SLOT)[row * 2 + 1]; const float w0 = wsp<float>(c, OFF_TOPW)[row * 2], w1 = wsp<float>(c, OFF_TOPW)[row * 2 + 1];
            const bf16* y0 = wsp<bf16>(c, OFF_YP) + (size_t)s0 * D_MODEL + 4 * lane; const bf16* y1 = wsp<bf16>(c, OFF_YP) + (size_t)s1 * D_MODEL + 4 * lane; const float* g5 = modp(c, comb_layer, mrow, 5) + 4 * lane;
#pragma unroll
            for (int j = 0; j < 4; ++j) { const u32x2 a = *(const u32x2*)(y0 + 256 * j), b = *(const u32x2*)(y1 + 256 * j); const f32x4 g = *(const f32x4*)(g5 + 256 * j);
                f32x4 y; y[0] = w0 * __uint_as_float(a.x << 16) + w1 * __uint_as_float(b.x << 16); y[1] = w0 * __uint_as_float(a.x & 0xffff0000u) + w1 * __uint_as_float(b.x & 0xffff0000u);
                y[2] = w0 * __uint_as_float(a.y << 16) + w1 * __uint_as_float(b.y << 16); y[3] = w0 * __uint_as_float(a.y & 0xffff0000u) + w1 * __uint_as_float(b.y & 0xffff0000u);
                v[j] = v[j] + g * y; xr[64 * j] = v[j]; }
        }
#pragma unroll
        for (int j = 0; j < 4; ++j) ss += (v[j][0] * v[j][0] + v[j][1] * v[j][1]) + (v[j][2] * v[j][2] + v[j][3] * v[j][3]);
        const float rstd = 1.0f / sqrtf(wave_sum(ss) * (1.0f / D_MODEL) + EPS);
        if (MODE == 2) {
#pragma unroll
            for (int j = 0; j < 4; ++j) { const f32x4 g = *(const f32x4*)(c.in[I_FINALG] + 4 * lane + 256 * j); *((f32x4*)(c.out + (size_t)row * D_MODEL) + lane + 64 * j) = v[j] * rstd * g; }
        } else {
            const float* gp = c.in[I_NORMG] + (layer * 2 + which) * D_MODEL + 4 * lane; const float* sh = modp(c, layer, mrow, which * 3) + 4 * lane; const float* sc = modp(c, layer, mrow, which * 3 + 1) + 4 * lane;
            float lg[NEXP];
#pragma unroll
            for (int e = 0; e < NEXP; ++e) lg[e] = 0.f;
#pragma unroll
            for (int j = 0; j < 4; ++j) { const f32x4 g = *(const f32x4*)(gp + 256 * j), s1 = *(const f32x4*)(sc + 256 * j), s0 = *(const f32x4*)(sh + 256 * j);
                const f32x4 y = v[j] * rstd * g * (s1 + 1.0f) + s0;
                u32x2 w; w.x = cvt_pk_bf16(y[0], y[1]); w.y = cvt_pk_bf16(y[2], y[3]); *(u32x2*)(H + (size_t)row * D_MODEL + 4 * lane + 256 * j) = w;
                if (MODE == 1) { const float* rp = c.in[I_MOE_R] + ((size_t)(layer / 2) * D_MODEL + 4 * lane + 256 * j) * NEXP;
#pragma unroll
                    for (int x = 0; x < 4; ++x) { const f32x4 r0 = *(const f32x4*)(rp + x * NEXP), r1 = *(const f32x4*)(rp + x * NEXP + 4);
                        lg[0] += y[x] * r0[0]; lg[1] += y[x] * r0[1]; lg[2] += y[x] * r0[2]; lg[3] += y[x] * r0[3]; lg[4] += y[x] * r1[0]; lg[5] += y[x] * r1[1]; lg[6] += y[x] * r1[2]; lg[7] += y[x] * r1[3]; } } }
            if (MODE == 1) {
#pragma unroll
                for (int e = 0; e < NEXP; ++e) lg[e] = wave_sum(lg[e]);
                if (lane == 0) { int i0, i1; float w0, w1; top2(lg, i0, i1, w0, w1);
                    wsp<int>(c, OFF_TOPI)[row * 2] = i0; wsp<int>(c, OFF_TOPI)[row * 2 + 1] = i1; wsp<float>(c, OFF_TOPW)[row * 2] = w0; wsp<float>(c, OFF_TOPW)[row * 2 + 1] = w1;
                    unsigned* cnt = wsp<unsigned>(c, OFF_CTL) + CW_CNT + 64 * (layer / 2); atomicAdd(cnt + i0, 1u); atomicAdd(cnt + i1, 1u); }
            }
        }
    }
}
DV void ph_ret_comb_gpu(const Ctx& c, int gw, int ngw, int lane) {
    static_assert(RET_DV == 512, "lane mapping");
    for (int it = gw; it < M_ALL * RET_H; it += ngw) {
        const int row = it / RET_H, h = it % RET_H; const size_t o = (size_t)row * RET_DVT + h * RET_DV + 8 * lane;
        const u32x4 a = *(const u32x4*)(wsp<bf16>(c, OFF_OF) + o), b = *(const u32x4*)(wsp<bf16>(c, OFF_OB) + o), g = *(const u32x4*)(wsp<bf16>(c, OFF_QKG) + (size_t)row * RET_NQKG + 2 * RET_DKT + h * RET_DV + 8 * lane);
        float ov[8], gv[8]; float ss = 0.f;
#pragma unroll
        for (int x = 0; x < 4; ++x) { ov[2 * x] = __uint_as_float(a[x] << 16) + __uint_as_float(b[x] << 16); ov[2 * x + 1] = __uint_as_float(a[x] & 0xffff0000u) + __uint_as_float(b[x] & 0xffff0000u);
            gv[2 * x] = __uint_as_float(g[x] << 16); gv[2 * x + 1] = __uint_as_float(g[x] & 0xffff0000u); ss += ov[2 * x] * ov[2 * x] + ov[2 * x + 1] * ov[2 * x + 1]; }
        const float rn = 1.0f / sqrtf(wave_sum(ss) * (1.0f / RET_DV) + EPS); const float* gn = c.in[I_RET_GN] + h * RET_DV + 8 * lane;
        float r[8];
#pragma unroll
        for (int x = 0; x < 8; ++x) r[x] = siluf_(gv[x]) * (ov[x] * rn) * gn[x];
        u32x4 w; w.x = cvt_pk_bf16(r[0], r[1]); w.y = cvt_pk_bf16(r[2], r[3]); w.z = cvt_pk_bf16(r[4], r[5]); w.w = cvt_pk_bf16(r[6], r[7]);
        *(u32x4*)(wsp<bf16>(c, OFF_A3) + o) = w;
    }
}

constexpr int RT_C = 64, RT_QS = 264, RT_TS = 72;
constexpr int RT_Q = 0, RT_K = RT_Q + RT_C * RT_QS * 2, RT_KT = RT_K + RT_C * RT_QS * 2, RT_VT = RT_KT + RET_DK * RT_TS * 2, RT_P = RT_VT + 128 * RT_TS * 2, RT_END = RT_P + RT_C * RT_TS * 2;
DV u32x4 rev8(u32x4 v) { u32x4 o; o.x = (v.w >> 16) | (v.w << 16); o.y = (v.z >> 16) | (v.z << 16); o.z = (v.y >> 16) | (v.y << 16); o.w = (v.x >> 16) | (v.x << 16); return o; }
DV void ph_ret_gpu(const Ctx& c, LAS unsigned char* lds, int bid, int nb, int tid) {
    static_assert(RET_DK == 256 && RET_DV == 512, "retention kernel geometry");
    asm volatile("" : "+v"(tid));
    const bf16* QKG = wsp<bf16>(c, OFF_QKG); const bf16* KVT = wsp<bf16>(c, OFF_KVT);
    const int lane = tid & 63, w = __builtin_amdgcn_readfirstlane(tid >> 6), fr = lane & 15, fq = lane >> 4;
    for (int item = bid; item < BATCH * RET_H * 2 * 4; item += nb) {
        const int eq = item & 3, dir = (item >> 2) & 1, h = (item >> 3) % RET_H, b = item / (8 * RET_H);
        bf16* OUT = wsp<bf16>(c, dir ? OFF_OB : OFF_OF);
        const float lg = c.in[I_RET_LD][dir * RET_H + h], cdec = __expf(lg * (float)RT_C);
        float kdec[8];
#pragma unroll
        for (int x = 0; x < 8; ++x) kdec[x] = __expf(lg * (float)(RT_C - 1 - (8 * (tid & 7) + x)));
        f32x4 st[16];
#pragma unroll
        for (int x = 0; x < 16; ++x) st[x] = (f32x4){0.f, 0.f, 0.f, 0.f};
        constexpr int NSTEP = (CTX + SEQ) / RT_C, NSC = CTX / RT_C;
        for (int s = 0; s < NSTEP; ++s) {
            int rlo;
            if (s < NSC) rlo = M_LAT + b * CTX + (dir ? CTX - RT_C * (s + 1) : RT_C * s);
            else rlo = b * SEQ + (dir ? SEQ - RT_C * (s - NSC + 1) : RT_C * (s - NSC));
            __syncthreads();
#pragma unroll
            for (int x = 0; x < 4; ++x) { const int p = tid + 512 * x, i = p >> 5, cp = p & 31; const int row = dir ? rlo + RT_C - 1 - i : rlo + i;
                const bf16* src = QKG + (size_t)row * RET_NQKG + h * RET_DK + 8 * cp;
                *(LAS u32x4*)(lds + RT_Q + (i * RT_QS + 8 * cp) * 2) = *(const u32x4*)src;
                *(LAS u32x4*)(lds + RT_K + (i * RT_QS + 8 * cp) * 2) = *(const u32x4*)(src + RET_DKT); }
#pragma unroll
            for (int x = 0; x < 4; ++x) { const int p = tid + 512 * x, dd = p >> 3, jp = p & 7;
                u32x4 v = *(const u32x4*)(KVT + (size_t)(h * RET_DK + dd) * M_ALL + rlo + (dir ? RT_C - 8 - 8 * jp : 8 * jp)); if (dir) v = rev8(v);
                *(LAS u32x4*)(lds + RT_KT + (dd * RT_TS + 8 * jp) * 2) = v; }
#pragma unroll
            for (int x = 0; x < 2; ++x) { const int p = tid + 512 * x, e = p >> 3, jp = p & 7;
                u32x4 v = *(const u32x4*)(KVT + (size_t)(RET_DKT + h * RET_DV + 128 * eq + e) * M_ALL + rlo + (dir ? RT_C - 8 - 8 * jp : 8 * jp)); if (dir) v = rev8(v);
                u32x4 o;
#pragma unroll
                for (int y = 0; y < 4; ++y) o[y] = cvt_pk_bf16(__uint_as_float(v[y] << 16) * kdec[2 * y], __uint_as_float(v[y] & 0xffff0000u) * kdec[2 * y + 1]);
                *(LAS u32x4*)(lds + RT_VT + (e * RT_TS + 8 * jp) * 2) = o; }
            __syncthreads();
            { const int it = w >> 1, jt0 = 2 * (w & 1); f32x4 aS[2] = {(f32x4){0.f, 0.f, 0.f, 0.f}, (f32x4){0.f, 0.f, 0.f, 0.f}};
#pragma unroll
                for (int ks = 0; ks < 8; ++ks) { const bf16x8 a = *(const LAS bf16x8*)(lds + RT_Q + ((16 * it + fr) * RT_QS + 32 * ks + 8 * fq) * 2);
#pragma unroll
                    for (int jj = 0; jj < 2; ++jj) { const bf16x8 bb = *(const LAS bf16x8*)(lds + RT_K + ((16 * (jt0 + jj) + fr) * RT_QS + 32 * ks + 8 * fq) * 2); aS[jj] = __builtin_amdgcn_mfma_f32_16x16x32_bf16(a, bb, aS[jj], 0, 0, 0); } }
#pragma unroll
                for (int jj = 0; jj < 2; ++jj)
#pragma unroll
                    for (int r = 0; r < 4; ++r) { const int i = 16 * it + 4 * fq + r, j = 16 * (jt0 + jj) + fr; *(LAS bf16*)(lds + RT_P + (i * RT_TS + j) * 2) = f2bf(j <= i ? aS[jj][r] : 0.f); } }
            f32x4 aO[4];
#pragma unroll
            for (int it = 0; it < 4; ++it) aO[it] = (f32x4){0.f, 0.f, 0.f, 0.f};
#pragma unroll
            for (int ks = 0; ks < 8; ++ks) {
                u32x4 bp; bp.x = cvt_pk_bf16(st[2 * ks][0], st[2 * ks][1]); bp.y = cvt_pk_bf16(st[2 * ks][2], st[2 * ks][3]); bp.z = cvt_pk_bf16(st[2 * ks + 1][0], st[2 * ks + 1][1]); bp.w = cvt_pk_bf16(st[2 * ks + 1][2], st[2 * ks + 1][3]);
                const bf16x8 bb = __builtin_bit_cast(bf16x8, bp);
#pragma unroll
                for (int it = 0; it < 4; ++it) { const LAS unsigned char* qp = lds + RT_Q + ((16 * it + fr) * RT_QS + 32 * ks + 4 * fq) * 2;
                    const u32x2 lo = *(const LAS u32x2*)qp, hi = *(const LAS u32x2*)(qp + 32); u32x4 ap; ap.x = lo.x; ap.y = lo.y; ap.z = hi.x; ap.w = hi.y;
                    aO[it] = __builtin_amdgcn_mfma_f32_16x16x32_bf16(__builtin_bit_cast(bf16x8, ap), bb, aO[it], 0, 0, 0); } }
#pragma unroll
            for (int it = 0; it < 4; ++it) aO[it] = aO[it] * cdec;
            __syncthreads();
            bf16x8 vb[2];
#pragma unroll
            for (int ks = 0; ks < 2; ++ks) vb[ks] = *(const LAS bf16x8*)(lds + RT_VT + ((16 * w + fr) * RT_TS + 32 * ks + 8 * fq) * 2);
#pragma unroll
            for (int it = 0; it < 4; ++it)
#pragma unroll
                for (int ks = 0; ks < 2; ++ks) { const bf16x8 a = *(const LAS bf16x8*)(lds + RT_P + ((16 * it + fr) * RT_TS + 32 * ks + 8 * fq) * 2); aO[it] = __builtin_amdgcn_mfma_f32_16x16x32_bf16(a, vb[ks], aO[it], 0, 0, 0); }
#pragma unroll
            for (int it = 0; it < 4; ++it)
#pragma unroll
                for (int r = 0; r < 4; ++r) { const int i = 16 * it + 4 * fq + r; const int row = dir ? rlo + RT_C - 1 - i : rlo + i;
                    OUT[(size_t)row * RET_DVT + h * RET_DV + 128 * eq + 16 * w + fr] = f2bf(aO[it][r] * __expf(lg * (float)(i - (RT_C - 1)))); }
#pragma unroll
            for (int dt = 0; dt < 16; ++dt) { st[dt] = st[dt] * cdec;
#pragma unroll
                for (int ks = 0; ks < 2; ++ks) { const bf16x8 a = *(const LAS bf16x8*)(lds + RT_KT + ((16 * dt + fr) * RT_TS + 32 * ks + 8 * fq) * 2); st[dt] = __builtin_amdgcn_mfma_f32_16x16x32_bf16(a, vb[ks], st[dt], 0, 0, 0); } }
        }
    }
    __syncthreads();
}

DV void ph_swa_gpu(const Ctx& c, LAS unsigned char* lds, int bid, int nb, int tid) {
    static_assert(SWA_DH == 64 && SWA_G == 4, "swa kernel geometry");
    asm volatile("" : "+v"(tid));
    const bf16* QKV = wsp<bf16>(c, OFF_QKV); bf16* AO = wsp<bf16>(c, OFF_AO);
    LAS float* Ks = (LAS float*)lds; LAS float* Vs = Ks + 64 * 64;
    constexpr int NBLK = SEQ / SWA_BLK, NL = BATCH * SWA_HKV * NBLK, NU = NL + BATCH * SWA_HKV * (CTX / 128);
    for (int u = bid; u < NU; u += nb) {
        int b, hk, n; bool isctx = u >= NL;
        if (!isctx) { b = u / (SWA_HKV * NBLK); hk = (u / NBLK) % SWA_HKV; n = u % NBLK; } else { const int v = u - NL; b = v / (SWA_HKV * (CTX / 128)); hk = (v / (CTX / 128)) % SWA_HKV; n = v % (CTX / 128); }
        const int gh = tid >> 7, qi = tid & 127, hq = hk * SWA_G + gh, t = 128 * n + qi;
        const int row = isctx ? M_LAT + b * CTX + t : b * SEQ + t;
        float q[64], o[64];
        { const u32x4* qp = (const u32x4*)(QKV + (size_t)row * SWA_N + hq * SWA_DH);
#pragma unroll
            for (int x = 0; x < 8; ++x) { const u32x4 v = qp[x];
#pragma unroll
                for (int y = 0; y < 4; ++y) { q[8 * x + 2 * y] = __uint_as_float(v[y] << 16) * 0.125f; q[8 * x + 2 * y + 1] = __uint_as_float(v[y] & 0xffff0000u) * 0.125f; } } }
#pragma unroll
        for (int x = 0; x < 64; ++x) o[x] = 0.f;
        float m = c.in[I_SWA_SINK][hq], l = 1.0f;
        const int ntile = isctx ? CTX / 64 : 6 + CTX / 64;
        for (int tl = 0; tl < ntile; ++tl) {
            int krow0, kp0 = 0; bool band = false;
            if (!isctx && tl < 6) { kp0 = (n - 1) * SWA_BLK + 64 * tl; if (kp0 < 0 || kp0 >= SEQ) continue; krow0 = b * SEQ + kp0; band = true; }
            else krow0 = M_LAT + b * CTX + 64 * (isctx ? tl : tl - 6);
            __syncthreads();
            { const int key = tid >> 3, d8 = (tid & 7) * 8; const bf16* kp = QKV + (size_t)(krow0 + key) * SWA_N + SWA_NQ + hk * SWA_DH + d8;
                const u32x4 kv = *(const u32x4*)kp, vv = *(const u32x4*)(kp + SWA_NKV);
                f32x4 a0, a1, b0, b1;
                a0[0] = __uint_as_float(kv.x << 16); a0[1] = __uint_as_float(kv.x & 0xffff0000u); a0[2] = __uint_as_float(kv.y << 16); a0[3] = __uint_as_float(kv.y & 0xffff0000u);
                a1[0] = __uint_as_float(kv.z << 16); a1[1] = __uint_as_float(kv.z & 0xffff0000u); a1[2] = __uint_as_float(kv.w << 16); a1[3] = __uint_as_float(kv.w & 0xffff0000u);
                b0[0] = __uint_as_float(vv.x << 16); b0[1] = __uint_as_float(vv.x & 0xffff0000u); b0[2] = __uint_as_float(vv.y << 16); b0[3] = __uint_as_float(vv.y & 0xffff0000u);
                b1[0] = __uint_as_float(vv.z << 16); b1[1] = __uint_as_float(vv.z & 0xffff0000u); b1[2] = __uint_as_float(vv.w << 16); b1[3] = __uint_as_float(vv.w & 0xffff0000u);
                *(LAS f32x4*)(Ks + key * 64 + d8) = a0; *(LAS f32x4*)(Ks + key * 64 + d8 + 4) = a1; *(LAS f32x4*)(Vs + key * 64 + d8) = b0; *(LAS f32x4*)(Vs + key * 64 + d8 + 4) = b1; }
            __syncthreads();
            for (int kb = 0; kb < 8; ++kb) {
                float s[8]; float mx = m;
#pragma unroll
                for (int k8 = 0; k8 < 8; ++k8) { const LAS float* kr = Ks + (kb * 8 + k8) * 64; float a = 0.f;
#pragma unroll
                    for (int d = 0; d < 64; ++d) a += q[d] * kr[d];
                    if (band) { const int df = t - (kp0 + kb * 8 + k8); if (df > SWA_WIN || df < -SWA_WIN) a = -1.0e30f; }
                    s[k8] = a; mx = fmaxf(mx, a); }
                const float corr = __expf(m - mx); l *= corr;
#pragma unroll
                for (int d = 0; d < 64; ++d) o[d] *= corr;
#pragma unroll
                for (int k8 = 0; k8 < 8; ++k8) { const float p = __expf(s[k8] - mx); l += p; const LAS float* vr = Vs + (kb * 8 + k8) * 64;
#pragma unroll
                    for (int d = 0; d < 64; ++d) o[d] += p * vr[d]; }
                m = mx;
            }
        }
        const float il = 1.0f / l; u32x4* op = (u32x4*)(AO + (size_t)row * SWA_NQ + hq * SWA_DH);
#pragma unroll
        for (int x = 0; x < 8; ++x) { u32x4 w; w.x = cvt_pk_bf16(o[8 * x] * il, o[8 * x + 1] * il); w.y = cvt_pk_bf16(o[8 * x + 2] * il, o[8 * x + 3] * il); w.z = cvt_pk_bf16(o[8 * x + 4] * il, o[8 * x + 5] * il); w.w = cvt_pk_bf16(o[8 * x + 6] * il, o[8 * x + 7] * il); op[x] = w; }
    }
    __syncthreads();
}

#ifndef MK_CHECK
#define MK_CHECK 0
#endif
#ifndef MK_CHECK_TOL
#define MK_CHECK_TOL 0.03f
#endif
constexpr int CK_NS = 1024, CK_NID = 64;
constexpr size_t OFF_CKBUF = OFF_CTL + (512u << 10);
DV unsigned hash32(unsigned x) { x ^= x >> 16; x *= 0x7feb352dU; x ^= x >> 15; x *= 0x846ca68bU; x ^= x >> 16; return x; }
DV void ck_add(const Ctx& c, int id, float got, float ref) { float* a = (float*)(wsp<unsigned>(c, OFF_CTL) + CW_CHK) + 2 * id; const float d = got - ref; atomicAdd(a, d * d); atomicAdd(a + 1, ref * ref + 1e-12f); }
DV void ck_sample(int id, int s, int nrows, int ncols, int& row, int& col) { const unsigned h = hash32((unsigned)(id * 7919 + s) * 2654435761u + 12345u); row = (int)(h % (unsigned)nrows); col = (int)(hash32(h + 0x9e3779b9u) % (unsigned)ncols); }
template <class F> DV void ck_gemm_plain(const Ctx& c, int id, const bf16* A, int lda, const float* W, int ldw, int K, const bf16* O, size_t ldo, int nrows, int ncols, F srccol, int gtid) {
    if (gtid < CK_NS) { int row, n; ck_sample(id, gtid, nrows, ncols, row, n); ck_add(c, id, bf2f(O[(size_t)row * ldo + n]), spec_dot(A + (size_t)row * lda, W, ldw, K, srccol(n))); }
}
DV void ck_resid_pre(const Ctx& c, int id, int nrows, int gtid) { if (gtid < CK_NS) { int row, n; ck_sample(id, gtid, nrows, D_MODEL, row, n); wsp<float>(c, OFF_CKBUF)[id * CK_NS + gtid] = wsp<float>(c, OFF_XL)[(size_t)row * D_MODEL + n]; } }
DV void ck_resid_post(const Ctx& c, int id, int layer, int which, const bf16* A, int lda, const float* W, int K, int nrows, int gtid) {
    if (gtid < CK_NS) { int row, n; ck_sample(id, gtid, nrows, D_MODEL, row, n); const RowInfo ri = row_info(row);
        const float got = wsp<float>(c, OFF_XL)[(size_t)row * D_MODEL + n] - wsp<float>(c, OFF_CKBUF)[id * CK_NS + gtid];
        ck_add(c, id, got, modp(c, layer, ri.mrow, which)[n] * spec_dot(A + (size_t)row * lda, W, D_MODEL, K, n)); }
}
DV void ck_norm(const Ctx& c, int id, int layer, int which, int nrows, int gtid) {
    if (gtid < CK_NS) { int row, col; ck_sample(id, gtid, nrows, D_MODEL, row, col); const float rstd = spec_rstd(wsp<float>(c, OFF_XL) + (size_t)row * D_MODEL);
        ck_add(c, id, bf2f(wsp<bf16>(c, OFF_H)[(size_t)row * D_MODEL + col]), spec_norm(c, layer, which, row, col, rstd)); }
}
DV void ck_router(const Ctx& c, int id, int layer, int nrows, int gtid) {
    if (gtid < CK_NS) { int row, col; ck_sample(id, gtid, nrows, 1, row, col); const float rstd = spec_rstd(wsp<float>(c, OFF_XL) + (size_t)row * D_MODEL);
        float lg[NEXP];
#pragma unroll
        for (int e = 0; e < NEXP; ++e) lg[e] = 0.f;
        for (int k = 0; k < D_MODEL; ++k) { const float v = spec_norm(c, layer, 1, row, k, rstd); const float* rp = c.in[I_MOE_R] + ((size_t)(layer / 2) * D_MODEL + k) * NEXP;
#pragma unroll
            for (int e = 0; e < NEXP; ++e) lg[e] += v * rp[e]; }
        int i0, i1; float w0, w1; top2(lg, i0, i1, w0, w1);
        const int g0 = wsp<int>(c, OFF_TOPI)[row * 2], g1 = wsp<int>(c, OFF_TOPI)[row * 2 + 1];
        if (g0 == i0 && g1 == i1) { ck_add(c, id, wsp<float>(c, OFF_TOPW)[row * 2], w0); ck_add(c, id, wsp<float>(c, OFF_TOPW)[row * 2 + 1], w1); } else ck_add(c, id, 0.f, 1.f); }
}
DV void ck_swiglu(const Ctx& c, int id, const bf16* A, const float* W, const int* tile_e, size_t wexp, const bf16* O, int nrows, int gtid) {
    if (gtid < CK_NS) { int row, x; ck_sample(id, gtid, nrows, D_FF, row, x); const float* We = W + (tile_e ? (size_t)tile_e[row / 256] * wexp : 0);
        const float g = spec_dot(A + (size_t)row * D_MODEL, We, 2 * D_FF, D_MODEL, x), u = spec_dot(A + (size_t)row * D_MODEL, We, 2 * D_FF, D_MODEL, D_FF + x);
        ck_add(c, id, bf2f(O[(size_t)row * D_FF + x]), siluf_(g) * u); }
}
DV void ck_moe_dn(const Ctx& c, int id, const float* W, const int* tile_e, int nrows, int gtid) {
    if (gtid < CK_NS) { int row, n; ck_sample(id, gtid, nrows, D_MODEL, row, n); const float* We = W + (size_t)tile_e[row / 256] * D_FF * D_MODEL;
        ck_add(c, id, bf2f(wsp<bf16>(c, OFF_YP)[(size_t)row * D_MODEL + n]), spec_dot(wsp<bf16>(c, OFF_HIDM) + (size_t)row * D_FF, We, D_MODEL, D_FF, n)); }
}
DV void ck_gate(const Ctx& c, int id, int j, int gtid) { if (gtid < CK_NS) { int row, n; ck_sample(id, gtid, M_ALL, 4 * LRU_W, row, n); ck_add(c, id, bf2f(wsp<bf16>(c, OFF_GT)[(size_t)row * 4 * LRU_W + n]), spec_gate(c, j, row, n / LRU_W, n % LRU_W)); } }
DV void ck_ret(const Ctx& c, int id, int dir, int gtid) { if (gtid < 256) { int row, n; ck_sample(id, gtid, M_ALL, RET_DVT, row, n); ck_add(c, id, bf2f(wsp<bf16>(c, dir ? OFF_OB : OFF_OF)[(size_t)row * RET_DVT + n]), spec_ret(c, row, n / RET_DV, n % RET_DV, dir)); } }
DV void ck_kvt(const Ctx& c, int id, int gtid) { if (gtid < CK_NS) { int tok, r; ck_sample(id, gtid, M_ALL, RET_NKV, tok, r);
    ck_add(c, id, bf2f(wsp<bf16>(c, OFF_KVT)[(size_t)r * M_ALL + tok]), spec_dot(wsp<bf16>(c, OFF_H) + (size_t)tok * D_MODEL, c.in[I_RET_WIN], 2 * RET_DKT + 2 * RET_DVT, D_MODEL, RET_DKT + r)); } }
DV void ck_retcomb(const Ctx& c, int id, int gtid) { if (gtid < CK_NS) { int row, n; ck_sample(id, gtid, M_ALL, RET_DVT, row, n); ck_add(c, id, bf2f(wsp<bf16>(c, OFF_A3)[(size_t)row * RET_DVT + n]), spec_ret_comb(c, row, n / RET_DV, n % RET_DV)); } }
DV void ck_swa(const Ctx& c, int id, int gtid) { if (gtid < CK_NS) { int row, n; ck_sample(id, gtid, M_ALL, SWA_NQ, row, n); ck_add(c, id, bf2f(wsp<bf16>(c, OFF_AO)[(size_t)row * SWA_NQ + n]), spec_swa(c, row, n / SWA_DH, n % SWA_DH)); } }

constexpr int LDS_BYTES = 147456, MISC_OFF = 143360;
static_assert(RT_END <= MISC_OFF && pg8::STAGE_BYTES <= MISC_OFF, "LDS map");

__global__ void __launch_bounds__(NTHREADS, 2) hybrid_fwd(Ctx c) {
    extern __shared__ __attribute__((aligned(16))) unsigned char lds_raw[];
    LAS unsigned char* lds = (LAS unsigned char*)lds_raw;
    const int tid = threadIdx.x, lane = tid & 63, wave = __builtin_amdgcn_readfirstlane(tid >> 6);
    const int G = gridDim.x, bid = blockIdx.x;
    const int gtid = bid * NTHREADS + tid, gn = G * NTHREADS, gw = bid * NWAVES + wave, ngw = G * NWAVES;
    volatile LAS unsigned* MISC = (volatile LAS unsigned*)(lds + MISC_OFF);
    if (tid < 64) MISC[tid] = 0u;
    __syncthreads();
    unsigned* ctl = wsp<unsigned>(c, OFF_CTL);
    XcdBarrier bar = xcd_barrier_post(ctl + CW_BAR, MISC + 8);
#define GRID_BAR() xcd_barrier(bar)
#if MK_CHECK
#define CK(...) do { __VA_ARGS__; GRID_BAR(); } while (0)
#else
#define CK(...) do { } while (0)
#endif
    const bf16* H = wsp<bf16>(c, OFF_H); float* XL = wsp<float>(c, OFF_XL);
    const size_t MODL = (size_t)NMOD * 6 * D_MODEL;

    ph_convert(c, lds, gw, ngw, lane, wave, gtid, gn);
    { LAS float* cond = (LAS float*)(lds + 8 * 8704);
      __syncthreads(); fill_cond(c, cond, tid, NTHREADS); __syncthreads();
      const int per = (DEPTH * 6 * D_MODEL + G - 1) / G;
      if (tid < per) { const int item = bid * per + tid; if (item < DEPTH * 6 * D_MODEL) ph_mod(c, cond, item, 1 << 30); } }
    ph_tables(c, gtid, gn); ph_copy_x(c, gtid, gn);
    GRID_BAR();

#define NORM1(L, COMBL) do { if ((COMBL) >= 0) ph_norm_gpu<0, true>(c, L, 0, M_ALL, COMBL, gw, ngw, lane); else ph_norm_gpu<0, false>(c, L, 0, M_ALL, 0, gw, ngw, lane); GRID_BAR(); CK(ck_norm(c, (L) * 12 + 0, L, 0, M_ALL, gtid)); } while (0)
#define GEMM_RESID(L, WHICH, Aoff, KK, Woff, NROWS, Wf32, CKID) do { \
        CK(ck_resid_pre(c, CKID, NROWS, gtid)); \
        pg8::Sched S; S.init((NROWS) / 256, D_MODEL / 256, G, bid, c.ws + (Aoff), (size_t)256 * (KK) * 2, c.ws + (Woff), (size_t)256 * (KK) * 2); \
        pg8::EpiResid E{XL, (size_t)D_MODEL, wsp<float>(c, OFF_MOD) + (size_t)(L) * MODL + (WHICH) * D_MODEL, (size_t)6 * D_MODEL}; \
        pg8::gemm_phase<pg8::EpiResid>(lds, KK, KK, KK, S, E); GRID_BAR(); \
        CK(ck_resid_post(c, CKID, L, WHICH, wsp<bf16>(c, Aoff), KK, Wf32, KK, NROWS, gtid)); } while (0)
#define FFN_DENSE(L, F, NROWS) do { \
        ph_norm_gpu<0, false>(c, L, 1, NROWS, 0, gw, ngw, lane); GRID_BAR(); CK(ck_norm(c, (L) * 12 + 7, L, 1, NROWS, gtid)); \
        { pg8::Sched S; S.init((NROWS) / 256, 2 * D_FF / 256, G, bid, c.ws + OFF_H, (size_t)256 * D_MODEL * 2, c.ws + OFF_W_FFN_GU + (F) * SZ_W_GU, (size_t)256 * D_MODEL * 2); \
          pg8::EpiSwiglu E{wsp<bf16>(c, OFF_HID), (size_t)D_FF}; pg8::gemm_phase<pg8::EpiSwiglu>(lds, D_MODEL, D_MODEL, D_MODEL, S, E); GRID_BAR(); } \
        CK(ck_swiglu(c, (L) * 12 + 9, H, c.in[I_FFN_GU] + (size_t)(F) * D_MODEL * 2 * D_FF, nullptr, 0, wsp<bf16>(c, OFF_HID), NROWS, gtid)); \
        GEMM_RESID(L, 5, OFF_HID, D_FF, OFF_W_FFN_DN + (F) * SZ_W_DN, NROWS, c.in[I_FFN_DN] + (size_t)(F) * D_FF * D_MODEL, (L) * 12 + 10); } while (0)
#define FFN_MOE(L, F, NROWS) do { \
        ph_norm_gpu<1, false>(c, L, 1, NROWS, 0, gw, ngw, lane); GRID_BAR(); CK(ck_norm(c, (L) * 12 + 7, L, 1, NROWS, gtid)); CK(ck_router(c, (L) * 12 + 8, L, NROWS, gtid)); \
        ph_moe_perm(c, F, NROWS, gtid, gn); GRID_BAR(); ph_moe_gather(c, F, NROWS, gtid, gn); GRID_BAR(); \
        const int ntile = moe_off(ctl + CW_CNT + 64 * (F), NEXP) / 256; \
        { pg8::Sched S; S.init(ntile, 2 * D_FF / 256, G, bid, c.ws + OFF_AG, (size_t)256 * D_MODEL * 2, c.ws + OFF_W_MOE_GU + (size_t)(F) * NEXP * SZ_W_GU, (size_t)256 * D_MODEL * 2); S.tile_e = wsp<int>(c, OFF_TILEE); S.b_exp = SZ_W_GU; \
          pg8::EpiSwiglu E{wsp<bf16>(c, OFF_HIDM), (size_t)D_FF}; pg8::gemm_phase<pg8::EpiSwiglu>(lds, D_MODEL, D_MODEL, D_MODEL, S, E); GRID_BAR(); } \
        CK(ck_swiglu(c, (L) * 12 + 9, wsp<bf16>(c, OFF_AG), c.in[I_MOE_GU] + (size_t)(F) * NEXP * D_MODEL * 2 * D_FF, wsp<int>(c, OFF_TILEE), (size_t)D_MODEL * 2 * D_FF, wsp<bf16>(c, OFF_HIDM), ntile * 256, gtid)); \
        { pg8::Sched S; S.init(ntile, D_MODEL / 256, G, bid, c.ws + OFF_HIDM, (size_t)256 * D_FF * 2, c.ws + OFF_W_MOE_DN + (size_t)(F) * NEXP * SZ_W_DN, (size_t)256 * D_FF * 2); S.tile_e = wsp<int>(c, OFF_TILEE); S.b_exp = SZ_W_DN; \
          pg8::EpiBf16 E{wsp<bf16>(c, OFF_YP), (size_t)D_MODEL}; pg8::gemm_phase<pg8::EpiBf16>(lds, D_FF, D_FF, D_FF, S, E); GRID_BAR(); } \
        CK(ck_moe_dn(c, (L) * 12 + 10, c.in[I_MOE_DN] + (size_t)(F) * NEXP * D_FF * D_MODEL, wsp<int>(c, OFF_TILEE), ntile * 256, gtid)); } while (0)
#define MIX_LRU(L, J, NROWS_OUT) do { \
        { pg8::Sched S; S.init(M_ALL / 256, 2 * LRU_W / 256, G, bid, c.ws + OFF_H, (size_t)256 * D_MODEL * 2, c.ws + OFF_W_LRU_IN + (J) * SZ_W_LRU_IN, (size_t)256 * D_MODEL * 2); \
          pg8::EpiBf16 E{wsp<bf16>(c, OFF_Y1), (size_t)2 * LRU_W}; pg8::gemm_phase<pg8::EpiBf16>(lds, D_MODEL, D_MODEL, D_MODEL, S, E); GRID_BAR(); } \
        CK(ck_gemm_plain(c, (L) * 12 + 1, H, D_MODEL, c.in[I_LRU_WIN] + (size_t)(J) * D_MODEL * 2 * LRU_W, 2 * LRU_W, D_MODEL, wsp<bf16>(c, OFF_Y1), (size_t)2 * LRU_W, M_ALL, 2 * LRU_W, [](int n) { return n; }, gtid)); \
        ph_conv(c, J, gtid, gn); GRID_BAR(); \
        { pg8::Sched S; S.init(M_ALL / 256, 4 * LRU_W / 256, G, bid, c.ws + OFF_U, (size_t)256 * LRU_W * 2, c.ws + OFF_W_LRU_G + (J) * SZ_W_LRU_G, (size_t)256 * 256 * 2); S.a_cmod = 5; S.a_cstep = 256 * 2; \
          pg8::EpiBf16 E{wsp<bf16>(c, OFF_GT), (size_t)4 * LRU_W}; pg8::gemm_phase<pg8::EpiBf16>(lds, 256, LRU_W, 256, S, E); GRID_BAR(); } \
        CK(ck_gate(c, (L) * 12 + 2, J, gtid)); \
        ph_scan1(c, J, gtid, gn); GRID_BAR(); ph_scan2(c, gtid, gn); GRID_BAR(); ph_scan3(c, J, NROWS_OUT, gtid, gn); GRID_BAR(); \
        GEMM_RESID(L, 2, OFF_A2, LRU_W, OFF_W_LRU_OUT + (J) * SZ_W_LRU_OUT, NROWS_OUT, c.in[I_LRU_WOUT] + (size_t)(J) * LRU_W * D_MODEL, (L) * 12 + 6); } while (0)

#ifndef NO_L0
    NORM1(0, -1);
#ifndef NO_L0M
    MIX_LRU(0, 0, M_ALL);
#endif
#ifndef NO_L0F
    FFN_DENSE(0, 0, M_ALL);
#endif
#endif
#ifndef NO_L1
    NORM1(1, -1);
    { pg8::Sched S; S.init(M_ALL / 256, RET_NQKG / 256, G, bid, c.ws + OFF_H, (size_t)256 * D_MODEL * 2, c.ws + OFF_W_RET_A, (size_t)256 * D_MODEL * 2);
      pg8::EpiBf16 E{wsp<bf16>(c, OFF_QKG), (size_t)RET_NQKG}; pg8::gemm_phase<pg8::EpiBf16>(lds, D_MODEL, D_MODEL, D_MODEL, S, E); }
    { pg8::Sched S; S.init(RET_NKV / 256, M_ALL / 256, G, bid, c.ws + OFF_W_RET_B, (size_t)256 * D_MODEL * 2, c.ws + OFF_H, (size_t)256 * D_MODEL * 2);
      pg8::EpiBf16 E{wsp<bf16>(c, OFF_KVT), (size_t)M_ALL}; pg8::gemm_phase<pg8::EpiBf16>(lds, D_MODEL, D_MODEL, D_MODEL, S, E); GRID_BAR(); }
    CK(ck_gemm_plain(c, 12 + 1, H, D_MODEL, c.in[I_RET_WIN], 2 * RET_DKT + 2 * RET_DVT, D_MODEL, wsp<bf16>(c, OFF_QKG), (size_t)RET_NQKG, M_ALL, RET_NQKG, [](int n) { return n < 2 * RET_DKT ? n : n + RET_DVT; }, gtid));
    CK(ck_kvt(c, 12 + 2, gtid));
    ph_ret_rope(c, gtid, gn); GRID_BAR();
#ifndef NO_RET
    ph_ret_gpu(c, lds, bid, G, tid);
#endif
    GRID_BAR();
    CK(ck_ret(c, 12 + 3, 0, gtid)); CK(ck_ret(c, 12 + 4, 1, gtid));
    ph_ret_comb_gpu(c, gw, ngw, lane); GRID_BAR();
    CK(ck_retcomb(c, 12 + 5, gtid));
    GEMM_RESID(1, 2, OFF_A3, RET_DVT, OFF_W_RET_OUT, M_ALL, c.in[I_RET_WOUT], 12 + 6);
#ifndef NO_L1F
    FFN_MOE(1, 0, M_ALL);
#endif
#endif
#ifndef NO_L2
    NORM1(2, 1);
    { pg8::Sched S; S.init(M_ALL / 256, SWA_N / 256, G, bid, c.ws + OFF_H, (size_t)256 * D_MODEL * 2, c.ws + OFF_W_SWA_IN, (size_t)256 * D_MODEL * 2);
      pg8::EpiBf16 E{wsp<bf16>(c, OFF_QKV), (size_t)SWA_N}; pg8::gemm_phase<pg8::EpiBf16>(lds, D_MODEL, D_MODEL, D_MODEL, S, E); GRID_BAR(); }
    CK(ck_gemm_plain(c, 24 + 1, H, D_MODEL, c.in[I_SWA_WIN], SWA_N, D_MODEL, wsp<bf16>(c, OFF_QKV), (size_t)SWA_N, M_ALL, SWA_N, [](int n) { return n; }, gtid));
    ph_swa_rope(c, gtid, gn); GRID_BAR();
#ifndef NO_SWA
    ph_swa_gpu(c, lds, bid, G, tid);
#endif
    GRID_BAR();
    CK(ck_swa(c, 24 + 3, gtid));
    GEMM_RESID(2, 2, OFF_AO, SWA_NQ, OFF_W_SWA_OUT, M_ALL, c.in[I_SWA_WOUT], 24 + 6);
    FFN_DENSE(2, 1, M_ALL);
#endif
#ifndef NO_L3
    NORM1(3, -1);
    MIX_LRU(3, 1, M_LAT);
    FFN_MOE(3, 1, M_LAT);
#endif
    ph_norm_gpu<2, true>(c, 3, 0, M_LAT, 3, gw, ngw, lane);
#if MK_CHECK
    GRID_BAR();
    { const float* a = (const float*)(ctl + CW_CHK); int bad = 0;
      for (int id = CK_NID - 1; id >= 0; --id) { const float sd = a[2 * id], sr = a[2 * id + 1]; if (sr > 0.f && sd > sr * (MK_CHECK_TOL * MK_CHECK_TOL)) bad = id + 1; }
      if (ctl[CW_BAR + XB_TMO]) bad = 80;
      if (bad) { const float v = sqrtf((float)bad); for (size_t i = gtid; i < (size_t)M_LAT * D_MODEL; i += gn) c.out[i] = v; } }
#endif
}

extern "C" void kernel_launch(void* const* d_in, const int* in_sizes, int n_in, void* d_out, int out_size, void* d_ws, size_t ws_size, hipStream_t stream) {
    static int grid = 0;
    if (grid == 0) {
        if (n_in != N_IN || out_size != M_LAT * D_MODEL || ws_size < WS_NEED) { fprintf(stderr, "kernel_launch: unexpected shapes (n_in %d, out %d, ws %zu, need %zu)\n", n_in, out_size, ws_size, (size_t)WS_NEED); grid = -1; return; }
        int dev = 0, cus = 0, per_cu = 0;
        if (hipGetDevice(&dev) != hipSuccess || hipDeviceGetAttribute(&cus, hipDeviceAttributeMultiprocessorCount, dev) != hipSuccess) { grid = -1; return; }
        if (hipFuncSetAttribute((const void*)hybrid_fwd, hipFuncAttributeMaxDynamicSharedMemorySize, LDS_BYTES) != hipSuccess) { fprintf(stderr, "kernel_launch: hipFuncSetAttribute failed\n"); grid = -1; return; }
        if (hipOccupancyMaxActiveBlocksPerMultiprocessor(&per_cu, (const void*)hybrid_fwd, NTHREADS, LDS_BYTES) != hipSuccess || per_cu < 1) fprintf(stderr, "kernel_launch: occupancy query says %d\n", per_cu);
        (void)hipGetLastError();
        grid = cus;
    }
    if (grid < 0) return;
    if (hipMemsetAsync((char*)d_ws + OFF_CTL, 0, SZ_CTL, stream) != hipSuccess) return;
    Ctx c{};
    for (int i = 0; i < N_IN; ++i) c.in[i] = (const float*)d_in[i];
    c.out = (float*)d_out; c.ws = (unsigned char*)d_ws;
    hipLaunchKernelGGL(hybrid_fwd, dim3(grid), dim3(NTHREADS), LDS_BYTES, stream, c);
}
#endif
```
